# Optimizing an MI355X kernel written in HIP

```python
import math
import jax, jax.numpy as jnp
from jax import lax
import numpy as np

D_MODEL = 1024
BATCH = 16
SEQ = 4096
DEPTH = 1

GRID_W = 64
HY_WIDTH = 512
HY_ORDER = 2
FILT_EMB = 33
FILT_BANDS = (FILT_EMB - 1) // 2
FILT_HID = 64
N_Q_HEADS = 8
N_KV_HEADS = 2
GROUP = N_Q_HEADS // N_KV_HEADS
HEAD_DIM = 64
AXIS_DIM = HEAD_DIM // 2
Q_BLOCK = 128
ROPE_THETA = 10000.0
FF_DIM = 2816
PLE_DIM = 256
EPS = 1e-6

ATT_Q = N_Q_HEADS * HEAD_DIM
ATT_KV = N_KV_HEADS * HEAD_DIM
IN_COLS = 3 * HY_WIDTH + ATT_Q + 2 * ATT_KV + 2 * D_MODEL
SPLITS = [3 * HY_WIDTH,
          3 * HY_WIDTH + ATT_Q,
          3 * HY_WIDTH + ATT_Q + ATT_KV,
          3 * HY_WIDTH + ATT_Q + 2 * ATT_KV,
          3 * HY_WIDTH + ATT_Q + 2 * ATT_KV + D_MODEL]

kernel_name = "hyena_gqa_gated_hybrid_encoder"


def rms_norm(x, g):
    xf = x.astype(jnp.float32)
    y = xf * lax.rsqrt(jnp.mean(xf * xf, axis=-1, keepdims=True) + EPS)
    return (y * g.astype(jnp.float32)).astype(x.dtype)


def swiglu(x, w_gate, w_up, w_down):
    return (jax.nn.silu(x @ w_gate) * (x @ w_up)) @ w_down


def short_conv(z, w, b):
    zp = jnp.pad(z, ((0, 0), (1, 1), (0, 0)))
    return zp[:, :-2] * w[0] + zp[:, 1:-1] * w[1] + zp[:, 2:] * w[2] + b


def hyena_filter_freq(L, w1, b1, f1, w2, b2, f2, w3, deltas):
    f32 = jnp.float32
    t = jnp.linspace(0.0, 1.0, L, dtype=f32)[:, None]
    w = (2.0 * math.pi / L) * jnp.arange(L, dtype=f32)
    bands = jnp.linspace(1e-4, FILT_BANDS - 1, FILT_BANDS, dtype=f32)
    ang = w[:, None] * bands[None, :]
    z = jnp.concatenate([t, jnp.cos(ang), -jnp.sin(ang)], axis=-1)
    h = jnp.sin(f1.astype(f32) * (z @ w1.astype(f32) + b1.astype(f32)))
    h = jnp.sin(f2.astype(f32) * (h @ w2.astype(f32) + b2.astype(f32)))
    h = (h @ w3.astype(f32)).reshape(L, HY_ORDER, 2, HY_WIDTH)
    h = h * jnp.exp(-t[:, :, None, None] * jnp.abs(deltas.astype(f32)))
    h_fwd, h_bwd = h[:, :, 0], h[:, :, 1]
    filt = jnp.concatenate([h_fwd[:1] + h_bwd[:1], h_fwd[1:],
                            jnp.zeros((1, HY_ORDER, HY_WIDTH), f32),
                            h_bwd[:0:-1]], axis=0)
    filt = filt / jnp.sum(jnp.abs(filt), axis=0, keepdims=True)
    return jnp.fft.rfft(filt, axis=0)


def long_conv(z, filt_f, bias):
    L = z.shape[1]
    zf32 = z.astype(jnp.float32)
    zf = jnp.fft.rfft(zf32, n=2 * L, axis=1)
    y = jnp.fft.irfft(zf * filt_f[None], n=2 * L, axis=1)[:, :L]
    return (y + zf32 * bias.astype(jnp.float32)).astype(z.dtype)


def hyena_branch(hy_in, short_w, short_b, filt_f, bias):
    z = short_conv(hy_in, short_w, short_b)
    hv, g1, g2 = jnp.split(z, 3, axis=-1)
    z = g1 * long_conv(hv, filt_f[:, 0], bias[0])
    return g2 * long_conv(z, filt_f[:, 1], bias[1])


def axial_rope(L):
    rows = L // GRID_W
    row = jnp.repeat(jnp.arange(rows, dtype=jnp.float32), GRID_W)
    col = jnp.tile(jnp.arange(GRID_W, dtype=jnp.float32), rows)
    inv = ROPE_THETA ** (-jnp.arange(0, AXIS_DIM, 2, dtype=jnp.float32) / AXIS_DIM)
    ang = jnp.concatenate([row[:, None] * inv, col[:, None] * inv], axis=-1)
    return jnp.cos(ang), jnp.sin(ang)


def apply_rope(x, cos, sin):
    xf = x.astype(jnp.float32).reshape(*x.shape[:-1], HEAD_DIM // 2, 2)
    x0, x1 = xf[..., 0], xf[..., 1]
    c = cos[None, :, None, :]
    s = sin[None, :, None, :]
    out = jnp.stack([x0 * c - x1 * s, x0 * s + x1 * c], axis=-1)
    return out.reshape(x.shape).astype(x.dtype)


def attention_branch(q, k, v, q_gain, k_gain, cos, sin):
    B, L, _ = q.shape
    q = q.reshape(B, L, N_Q_HEADS, HEAD_DIM)
    k = k.reshape(B, L, N_KV_HEADS, HEAD_DIM)
    v = v.reshape(B, L, N_KV_HEADS, HEAD_DIM)
    q = apply_rope(rms_norm(q, q_gain), cos, sin)
    k = apply_rope(rms_norm(k, k_gain), cos, sin)
    n_blocks = L // Q_BLOCK
    qb = q.reshape(B, n_blocks, Q_BLOCK, N_KV_HEADS, GROUP, HEAD_DIM)
    qb = jnp.moveaxis(qb, 1, 0)
    scale = HEAD_DIM ** -0.5

    def attend(q_blk):
        s = jnp.einsum("bqkgd,bskd->bkgqs", q_blk, k,
                       preferred_element_type=jnp.float32) * scale
        w = jax.nn.softmax(s, axis=-1).astype(v.dtype)
        return jnp.einsum("bkgqs,bskd->bqkgd", w, v)

    o = lax.map(attend, qb)
    return jnp.moveaxis(o, 0, 1).reshape(B, L, ATT_Q)


def setup_inputs(seed: int = 0) -> dict:
    key = jax.random.key(seed)
    keys = iter(list(jax.random.split(key, 40)))
    f32 = jnp.float32

    def normal(shape, scale):
        return jax.random.normal(next(keys), shape, f32) * scale

    def gain(n):
        return 1.0 + 0.05 * normal((DEPTH, n), 1.0)

    min_decay = math.log(1e-2) / 1.5
    max_decay = math.log(1e-2) / 0.3
    base_deltas = jnp.linspace(min_decay, max_decay, HY_WIDTH, dtype=f32)

    inputs = {}
    inputs["x"] = normal((BATCH, SEQ, D_MODEL), 1.0)
    inputs["p"] = normal((DEPTH, BATCH, SEQ, PLE_DIM), 1.0)
    inputs["ffn1_norm_pre"] = gain(D_MODEL)
    inputs["ffn1_norm_post"] = gain(D_MODEL)
    inputs["ffn1_w_gate"] = normal((DEPTH, D_MODEL, FF_DIM), D_MODEL ** -0.5)
    inputs["ffn1_w_up"] = normal((DEPTH, D_MODEL, FF_DIM), D_MODEL ** -0.5)
    inputs["ffn1_w_down"] = normal((DEPTH, FF_DIM, D_MODEL), FF_DIM ** -0.5)
    inputs["mix_norm_pre"] = gain(D_MODEL)
    inputs["mix_norm_post"] = gain(D_MODEL)
    inputs["w_in"] = normal((DEPTH, D_MODEL, IN_COLS), D_MODEL ** -0.5)
    inputs["hy_short_w"] = normal((DEPTH, 3, 3 * HY_WIDTH), 3 ** -0.5)
    inputs["hy_short_b"] = normal((DEPTH, 3 * HY_WIDTH), 0.02)
    inputs["filt_w1"] = normal((DEPTH, FILT_EMB, FILT_HID), FILT_EMB ** -0.5)
    inputs["filt_b1"] = normal((DEPTH, FILT_HID), 0.1)
    inputs["filt_freq1"] = 1.0 + 0.01 * normal((DEPTH, FILT_HID), 1.0)
    inputs["filt_w2"] = normal((DEPTH, FILT_HID, FILT_HID), FILT_HID ** -0.5)
    inputs["filt_b2"] = normal((DEPTH, FILT_HID), 0.1)
    inputs["filt_freq2"] = 1.0 + 0.01 * normal((DEPTH, FILT_HID), 1.0)
    inputs["filt_w3"] = normal((DEPTH, FILT_HID, HY_ORDER * 2 * HY_WIDTH), FILT_HID ** -0.5)
    inputs["filt_deltas"] = base_deltas + 0.01 * normal((DEPTH, HY_ORDER, 2, HY_WIDTH), 1.0)
    inputs["hy_bias"] = normal((DEPTH, HY_ORDER, HY_WIDTH), 1.0)
    inputs["q_norm"] = gain(HEAD_DIM)
    inputs["k_norm"] = gain(HEAD_DIM)
    inputs["w_hy_out"] = normal((DEPTH, HY_WIDTH, D_MODEL), HY_WIDTH ** -0.5)
    inputs["w_att_out"] = normal((DEPTH, ATT_Q, D_MODEL), ATT_Q ** -0.5)
    inputs["w_out"] = normal((DEPTH, D_MODEL, D_MODEL), D_MODEL ** -0.5)
    inputs["ffn2_norm_pre"] = gain(D_MODEL)
    inputs["ffn2_norm_post"] = gain(D_MODEL)
    inputs["ffn2_w_gate"] = normal((DEPTH, D_MODEL, FF_DIM), D_MODEL ** -0.5)
    inputs["ffn2_w_up"] = normal((DEPTH, D_MODEL, FF_DIM), D_MODEL ** -0.5)
    inputs["ffn2_w_down"] = normal((DEPTH, FF_DIM, D_MODEL), FF_DIM ** -0.5)
    inputs["ple_norm_pre"] = gain(D_MODEL)
    inputs["ple_norm_post"] = gain(D_MODEL)
    inputs["w_ple_gate"] = normal((DEPTH, D_MODEL, D_MODEL), D_MODEL ** -0.5)
    inputs["w_ple_proj"] = normal((DEPTH, PLE_DIM, D_MODEL), PLE_DIM ** -0.5)
    return inputs


def reference(x, p, ffn1_norm_pre, ffn1_norm_post, ffn1_w_gate, ffn1_w_up, ffn1_w_down,
              mix_norm_pre, mix_norm_post, w_in, hy_short_w, hy_short_b,
              filt_w1, filt_b1, filt_freq1, filt_w2, filt_b2, filt_freq2, filt_w3,
              filt_deltas, hy_bias, q_norm, k_norm, w_hy_out, w_att_out, w_out,
              ffn2_norm_pre, ffn2_norm_post, ffn2_w_gate, ffn2_w_up, ffn2_w_down,
              ple_norm_pre, ple_norm_post, w_ple_gate, w_ple_proj):
    L = x.shape[1]
    rope_cos, rope_sin = axial_rope(L)
    for i in range(DEPTH):
        h = swiglu(rms_norm(x, ffn1_norm_pre[i]), ffn1_w_gate[i], ffn1_w_up[i], ffn1_w_down[i])
        x = x + 0.5 * rms_norm(h, ffn1_norm_post[i])

        u = rms_norm(x, mix_norm_pre[i])
        proj = u @ w_in[i]
        hy_in, q, k, v, gate_a, gate_b = jnp.split(proj, SPLITS, axis=-1)

        filt_f = hyena_filter_freq(L, filt_w1[i], filt_b1[i], filt_freq1[i], filt_w2[i],
                                   filt_b2[i], filt_freq2[i], filt_w3[i], filt_deltas[i])
        y_a = hyena_branch(hy_in, hy_short_w[i], hy_short_b[i], filt_f, hy_bias[i])
        y_b = attention_branch(q, k, v, q_norm[i], k_norm[i], rope_cos, rope_sin)

        merged = (jax.nn.sigmoid(gate_a) * (y_a @ w_hy_out[i])
                  + jax.nn.sigmoid(gate_b) * (y_b @ w_att_out[i]))
        x = x + rms_norm(merged @ w_out[i], mix_norm_post[i])

        h = swiglu(rms_norm(x, ffn2_norm_pre[i]), ffn2_w_gate[i], ffn2_w_up[i], ffn2_w_down[i])
        x = x + 0.5 * rms_norm(h, ffn2_norm_post[i])

        g = jax.nn.sigmoid(rms_norm(x, ple_norm_pre[i]) @ w_ple_gate[i])
        x = x + rms_norm(g * (p[i] @ w_ple_proj[i]), ple_norm_post[i])
    return x
```

```cpp
#include <hip/hip_runtime.h>
#include <hip/hip_cooperative_groups.h>
#include <hip/hip_bf16.h>
#include <cstdio>
#include <cstdint>
#include <cmath>
namespace cg = cooperative_groups;
constexpr int DM_ = 1024, BATCH = 16, SEQ = 4096, M = BATCH * SEQ, FF = 2816, HYW = 512, PLE = 256, INC = 4352;
constexpr float EPS = 1e-6f;
constexpr float QSCALE = 0.125f * 1.4426950408889634f;
constexpr size_t MiB = 1u << 20;
constexpr size_t WS_GU1 = 1 * MiB, WS_D1 = 12 * MiB, WS_IN = 18 * MiB, WS_HYO = 27 * MiB, WS_ATO = 28 * MiB, WS_OUT = 29 * MiB, WS_GU2 = 31 * MiB, WS_D2 = 42 * MiB, WS_PG = 48 * MiB, WS_PP = 50 * MiB;
constexpr size_t WS_FILT = 52 * MiB, WS_H2 = 68 * MiB, WS_ROPE = 69 * MiB, WS_RS = 70 * MiB, WS_PART = 71 * MiB;
constexpr size_t WS_XB = 76 * MiB, WS_HB = 204 * MiB, WS_BIG = 332 * MiB;
constexpr size_t WS_ACT = WS_BIG, WS_HYT = WS_BIG, WS_SGA = 524 * MiB, WS_SGB = 652 * MiB, WS_Q = 780 * MiB, WS_K = 844 * MiB, WS_V = 860 * MiB, WS_YA = 876 * MiB, WS_MRG = WS_BIG;
constexpr size_t WS_PB = WS_BIG, WS_PBUF = 364 * MiB, WS_YB = 940 * MiB, WS_END = 1004 * MiB;
namespace pg8 {
#define PG8_LAS __attribute__((address_space(3)))
typedef unsigned short bf16_t;
typedef short bf16x8 __attribute__((ext_vector_type(8)));
typedef float f32x4 __attribute__((ext_vector_type(4)));
typedef unsigned u32x4 __attribute__((ext_vector_type(4)));
constexpr int BM = 256, BK = 64, HALF = 128, HTB = HALF * BK * 2  , STAGE_BYTES = 8 * HTB, NXCD = 8, WGM = 8;

__host__ __device__ __forceinline__ int lds_byte(int r, int c) { const int st = (r >> 4) * 2 + (c >> 5), rr = r & 15, cc = c & 31, ob = rr * 64 + cc * 2; return st * 1024 + (ob ^ (((ob >> 9) & 1) << 5)); }
__host__ __device__ __forceinline__ void stage_rc(int b, int& R, int& C) { const int st = b / 1024, sb = b % 1024, swz = sb ^ (((sb >> 9) & 1) << 5); R = (st >> 1) * 16 + swz / 64; C = (st & 1) * 32 + (swz % 64) / 2; }
__host__ __device__ __forceinline__ int perm32(int rho) { const int n = rho >> 4, i = rho & 15; return 8 * (i >> 2) + 4 * n + (i & 3); }

struct Unit { int pm, pn, half; };
struct Gemm { const bf16_t* A; const bf16_t* Bt; int M, N, K; const bf16_t* A2; const bf16_t* Bt2; };

struct StaticOrder {
    int nM, nN, nwg, G, c, dual;
    __host__ __device__ void init(int M, int N, int G_, int c_) { nM = M / BM; nN = N / BM; nwg = nM * nN; G = G_; c = c_; dual = 0; }
    __host__ __device__ bool next(int i, Unit& u) const {
        const int ii = dual ? (i >> 1) : i; u.half = dual ? (i & 1) : 0;
        const long L = (long)ii * G + c; if (L >= nwg) return false;
        int wgid = (int)L; { const int q = nwg / NXCD, r = nwg % NXCD, xcd = wgid % NXCD, off = wgid / NXCD; wgid = (xcd < r ? xcd * (q + 1) : r * (q + 1) + (xcd - r) * q) + off; }
        const int nig = WGM * nN, gid = wgid / nig, fm = gid * WGM, gsz = (nM - fm) < WGM ? (nM - fm) : WGM;
        u.pm = fm + ((wgid % nig) % gsz); u.pn = (wgid % nig) / gsz; return true;
    }
    __device__ __forceinline__ void a_ready(const Unit&) const {}
    __device__ __forceinline__ void done(const Unit&) const {}
};

__device__ __forceinline__ unsigned cvt_pk_bf16(float lo, float hi) { unsigned r; asm volatile("v_cvt_pk_bf16_f32 %0, %1, %2" : "=v"(r) : "v"(lo), "v"(hi)); return r; }
typedef float f32x2 __attribute__((ext_vector_type(2)));
enum { EM_SWIGLU = 0, EM_HSUM = 1, EM_HYT = 2, EM_QKVG = 3, EM_MERGEA = 4, EM_MERGEB = 5, EM_PLAIN = 6, EM_PLEG = 7 };
__device__ __forceinline__ void st8(bf16_t* p, f32x4 v0, f32x4 v1) { u32x4 w; w.x = cvt_pk_bf16(v0[0], v0[1]); w.y = cvt_pk_bf16(v0[2], v0[3]); w.z = cvt_pk_bf16(v1[0], v1[1]); w.w = cvt_pk_bf16(v1[2], v1[3]); __builtin_nontemporal_store(w, (u32x4*)p); }
__device__ __forceinline__ void ld8(const bf16_t* p, f32x4& v0, f32x4& v1) { const u32x4 w = *(const u32x4*)p;
    v0[0] = __uint_as_float(w.x << 16); v0[1] = __uint_as_float(w.x & 0xffff0000u); v0[2] = __uint_as_float(w.y << 16); v0[3] = __uint_as_float(w.y & 0xffff0000u);
    v1[0] = __uint_as_float(w.z << 16); v1[1] = __uint_as_float(w.z & 0xffff0000u); v1[2] = __uint_as_float(w.w << 16); v1[3] = __uint_as_float(w.w & 0xffff0000u); }
__device__ __forceinline__ void un8(const u32x4 w, f32x4& v0, f32x4& v1) {
    v0[0] = __uint_as_float(w.x << 16); v0[1] = __uint_as_float(w.x & 0xffff0000u); v0[2] = __uint_as_float(w.y << 16); v0[3] = __uint_as_float(w.y & 0xffff0000u);
    v1[0] = __uint_as_float(w.z << 16); v1[1] = __uint_as_float(w.z & 0xffff0000u); v1[2] = __uint_as_float(w.w << 16); v1[3] = __uint_as_float(w.w & 0xffff0000u); }
__device__ __forceinline__ float sigm(float x) { return __builtin_amdgcn_rcpf(1.0f + __builtin_amdgcn_exp2f(-1.4426950408889634f * x)); }
__device__ __forceinline__ f32x4 sigm4(f32x4 v) { f32x4 o; o[0] = sigm(v[0]); o[1] = sigm(v[1]); o[2] = sigm(v[2]); o[3] = sigm(v[3]); return o; }
__device__ __forceinline__ float sq4(f32x4 v) { return (v[0] * v[0] + v[1] * v[1]) + (v[2] * v[2] + v[3] * v[3]); }
struct EpiGen {
    static constexpr bool PERM = true, AFTER_DRAIN = false;
    int mode; int ldc; int midk;
    bf16_t* O;
    const bf16_t* aux;
    unsigned char* ws;
    __device__ __forceinline__ void mid(f32x4 (&acc)[2][2][4][2], const Unit& u, int wr, int wc, int fr, int fq) const {
        const int row0 = u.pm * BM + wr * 64 + fr, cw = wc * 32 + 8 * fq;
        const bf16_t* sga = (const bf16_t*)(ws + WS_SGA); const bf16_t* sgb = (const bf16_t*)(ws + WS_SGB);
#pragma unroll
        for (int ai = 0; ai < 2; ++ai)
#pragma unroll
        for (int mh = 0; mh < 2; ++mh) {
            u32x4 ga[2][2], gb[2][2];
#pragma unroll
            for (int ml = 0; ml < 2; ++ml)
#pragma unroll
                for (int bj = 0; bj < 2; ++bj) { const size_t off = (size_t)(row0 + ai * HALF + (2 * mh + ml) * 16) * DM_ + u.pn * BM + bj * HALF + cw; ga[ml][bj] = *(const u32x4*)(sga + off); gb[ml][bj] = *(const u32x4*)(sgb + off); }
#pragma unroll
            for (int ml = 0; ml < 2; ++ml)
#pragma unroll
                for (int bj = 0; bj < 2; ++bj) { f32x4 a0, a1, b0, b1; un8(ga[ml][bj], a0, a1); un8(gb[ml][bj], b0, b1); const int m = 2 * mh + ml;
#pragma unroll
                    for (int j = 0; j < 4; ++j) { acc[ai][bj][m][0][j] *= a0[j] * __builtin_amdgcn_rcpf(b0[j]); acc[ai][bj][m][1][j] *= a1[j] * __builtin_amdgcn_rcpf(b1[j]); } }
            asm volatile("" ::: "memory");
        }
    }
    __device__ __forceinline__ void operator()(const f32x4 (&acc)[2][2][4][2], const Unit& u, int wr, int wc, int fr, int fq) const {
        const int row0 = u.pm * BM + wr * 64 + fr, cw = wc * 32 + 8 * fq;
        const float* rs = (const float*)(ws + WS_RS); float* part = (float*)(ws + WS_PART);
        bf16_t *oq = (bf16_t*)(ws + WS_Q), *ok = (bf16_t*)(ws + WS_K), *ov = (bf16_t*)(ws + WS_V), *oga = (bf16_t*)(ws + WS_SGA), *ogb = (bf16_t*)(ws + WS_SGB);
        if (mode == EM_SWIGLU) {
            float r8[2][4];
#pragma unroll
            for (int ai = 0; ai < 2; ++ai)
#pragma unroll
                for (int m = 0; m < 4; ++m) r8[ai][m] = rs[row0 + ai * HALF + m * 16];
#pragma unroll
            for (int ai = 0; ai < 2; ++ai)
#pragma unroll
                for (int m = 0; m < 4; ++m) { const int row = row0 + ai * HALF + m * 16; const float r = r8[ai][m]; f32x4 o[2];
#pragma unroll
                    for (int n = 0; n < 2; ++n) { const f32x4 g = acc[ai][0][m][n] * r, up = acc[ai][1][m][n] * r; o[n] = g * sigm4(g) * up; }
                    st8(O + (size_t)row * FF + u.pn * HALF + cw, o[0], o[1]); }
        } else if (mode == EM_HSUM) {
#pragma unroll
            for (int ai = 0; ai < 2; ++ai)
#pragma unroll
                for (int m = 0; m < 4; ++m) { const int row = row0 + ai * HALF + m * 16; float ss = 0.f;
#pragma unroll
                    for (int bj = 0; bj < 2; ++bj) { const size_t off = (size_t)row * DM_ + u.pn * BM + bj * HALF + cw; const f32x4 v0 = acc[ai][bj][m][0], v1 = acc[ai][bj][m][1];
                        ss += sq4(v0) + sq4(v1); st8(O + off, v0, v1); }
                    ss += __shfl_xor(ss, 16); ss += __shfl_xor(ss, 32);
                    if (fq == 0) part[(size_t)row * 16 + u.pn * 4 + wc] = ss; }
        } else if (mode == EM_HYT) {
            f32x4 rc[2][2];
#pragma unroll
            for (int bj = 0; bj < 2; ++bj) { const int col = u.pn * BM + bj * HALF + cw; rc[bj][0] = *(const f32x4*)(rs + col); rc[bj][1] = *(const f32x4*)(rs + col + 4); }
#pragma unroll
            for (int bj = 0; bj < 2; ++bj) { const int col = u.pn * BM + bj * HALF + cw;
#pragma unroll
                for (int ai = 0; ai < 2; ++ai)
#pragma unroll
                    for (int m = 0; m < 4; ++m) { const int row = row0 + ai * HALF + m * 16; st8(O + (size_t)row * M + col, acc[ai][bj][m][0] * rc[bj][0], acc[ai][bj][m][1] * rc[bj][1]); } }
        } else if (mode == EM_QKVG) {
            const int pn = u.pn;
            float r8[2][4];
#pragma unroll
            for (int ai = 0; ai < 2; ++ai)
#pragma unroll
                for (int m = 0; m < 4; ++m) r8[ai][m] = rs[row0 + ai * HALF + m * 16];
#pragma unroll
            for (int ai = 0; ai < 2; ++ai)
#pragma unroll
                for (int m = 0; m < 4; ++m) { const int row = row0 + ai * HALF + m * 16; const float r = r8[ai][m];
#pragma unroll
                    for (int bj = 0; bj < 2; ++bj) { f32x4 v0 = acc[ai][bj][m][0] * r, v1 = acc[ai][bj][m][1] * r; const int ct = bj * HALF + cw;
                        if (pn < 2) st8(oq + (size_t)row * 512 + pn * BM + ct, v0, v1);
                        else if (pn == 2) st8((bj == 0 ? ok : ov) + (size_t)row * 128 + cw, v0, v1);
                        else if (pn < 7) st8(oga + (size_t)row * 1024 + (pn - 3) * BM + ct, sigm4(v0), sigm4(v1));
                        else st8(ogb + (size_t)row * 1024 + (pn - 7) * BM + ct, sigm4(v0), sigm4(v1)); } }
        } else {
#pragma unroll
            for (int ai = 0; ai < 2; ++ai)
#pragma unroll
            for (int mh = 0; mh < 2; ++mh) {
                u32x4 ga[2][2], pa[2][2]; float rg[2] = {1.f, 1.f};
                if (mode == EM_PLEG) { rg[0] = rs[row0 + ai * HALF + (2 * mh) * 16]; rg[1] = rs[row0 + ai * HALF + (2 * mh + 1) * 16]; }
                if (mode != EM_PLAIN) {
#pragma unroll
                    for (int ml = 0; ml < 2; ++ml)
#pragma unroll
                        for (int bj = 0; bj < 2; ++bj) { const size_t off = (size_t)(row0 + ai * HALF + (2 * mh + ml) * 16) * DM_ + u.pn * BM + bj * HALF + cw; ga[ml][bj] = *(const u32x4*)(aux + off);
                            if (mode == EM_MERGEB) pa[ml][bj] = *(const u32x4*)(O + off); }
                }
#pragma unroll
                for (int ml = 0; ml < 2; ++ml) { const int m = 2 * mh + ml; const int row = row0 + ai * HALF + m * 16; float ss = 0.f; const float r = rg[ml];
#pragma unroll
                    for (int bj = 0; bj < 2; ++bj) { const size_t off = (size_t)row * DM_ + u.pn * BM + bj * HALF + cw; f32x4 v0 = acc[ai][bj][m][0], v1 = acc[ai][bj][m][1];
                        if (mode != EM_PLAIN) { f32x4 g0, g1; un8(ga[ml][bj], g0, g1);
                            if (mode == EM_PLEG) { v0 = sigm4(v0 * r) * g0; v1 = sigm4(v1 * r) * g1; } else { v0 = v0 * g0; v1 = v1 * g1; } }
                        if (mode == EM_MERGEB) { f32x4 p0, p1; un8(pa[ml][bj], p0, p1); v0 = v0 + p0; v1 = v1 + p1; }
                        if (mode == EM_PLEG) ss += sq4(v0) + sq4(v1);
                        st8(O + off, v0, v1); }
                    if (mode == EM_PLEG) { ss += __shfl_xor(ss, 16); ss += __shfl_xor(ss, 32); if (fq == 0) part[(size_t)row * 16 + u.pn * 4 + wc] = ss; } }
                asm volatile("" ::: "memory");
            }
        }
    }
};
template <class Epi, class Sched, bool ALIGN_EPI = false, bool SP2 = false>
__device__ __forceinline__ void gemm_phase(PG8_LAS unsigned char* lds, const Gemm g, const Sched& S, const Epi& E) {
    int tid_o = threadIdx.x; asm volatile("" : "+v"(tid_o)); const int tid = tid_o, wid = __builtin_amdgcn_readfirstlane(tid >> 6), lane = tid & 63, wr = wid >> 2, wc = wid & 3, fr = lane & 15, fq = lane >> 4;
    const int K = g.K, nt = K / BK;
    unsigned voffA[2], voffB[2];
#pragma unroll
    for (int i = 0; i < 2; ++i) { int R, C; stage_rc(tid * 16 + i * 8192, R, C); const int Rb = Epi::PERM ? ((R & ~31) + perm32(R & 31)) : R;
        voffA[i] = (unsigned)(R * K + C) * 2u; voffB[i] = (unsigned)(Rb * K + C) * 2u; }
    const size_t kstep = (size_t)(BK * 2);
    const size_t hstep = (size_t)HALF * K * 2;
    const size_t tstep = 2 * hstep;
    const unsigned ldsw = (unsigned)wid * 1024u;
    const int aoff = lds_byte(wr * 64 + fr, fq * 8), boff = lds_byte(wc * 32 + fr, fq * 8);
#define PG8_SA(b, h) (((b) * 2 + (h)) * HTB)
#define PG8_SB(b, h) ((4 + (b) * 2 + (h)) * HTB)
#define PG8_STAGE(bufoff, gbase, voff) do { _Pragma("unroll") for (int _i = 0; _i < 2; ++_i) \
        __builtin_amdgcn_global_load_lds((const unsigned*)((const char*)(gbase) + (voff)[_i]), (PG8_LAS unsigned*)(lds + (bufoff) + ldsw + _i * 8192), 16, 0, 0); } while (0)
#define PG8_LDA(dst, b, h) do { _Pragma("unroll") for (int m = 0; m < 4; ++m) _Pragma("unroll") for (int k = 0; k < 2; ++k) dst[m][k] = *(const PG8_LAS bf16x8*)(lds + PG8_SA(b, h) + aoff + m * 2048 + k * 1024); } while (0)
#define PG8_LDB(dst, b, h) do { _Pragma("unroll") for (int n = 0; n < 2; ++n) _Pragma("unroll") for (int k = 0; k < 2; ++k) dst[n][k] = *(const PG8_LAS bf16x8*)(lds + PG8_SB(b, h) + boff + n * 2048 + k * 1024); } while (0)
#define PG8_MMA(ai, bj, At, Bt) do { __builtin_amdgcn_s_setprio(1); _Pragma("unroll") for (int m = 0; m < 4; ++m) _Pragma("unroll") for (int n = 0; n < 2; ++n) _Pragma("unroll") for (int k = 0; k < 2; ++k) \
        acc[ai][bj][m][n] = __builtin_amdgcn_mfma_f32_16x16x32_bf16(Bt[n][k], At[m][k], acc[ai][bj][m][n], 0, 0, 0); __builtin_amdgcn_s_setprio(0); } while (0)
#define PG8_WAIT_V(n) asm volatile("s_waitcnt vmcnt(" #n ")" ::: "memory")
#define PG8_WAIT_L(n) asm volatile("s_waitcnt lgkmcnt(" #n ")" ::: "memory")
#define PG8_BAR __builtin_amdgcn_s_barrier()
#define PG8_SCHED __builtin_amdgcn_sched_barrier(0)
    Unit cur, nxt; int ui = 0;
    if (!S.next(0, cur)) return;
    f32x4 acc[2][2][4][2];
#pragma unroll
    for (int a = 0; a < 2; ++a)
#pragma unroll
        for (int b = 0; b < 2; ++b)
#pragma unroll
            for (int m = 0; m < 4; ++m)
#pragma unroll
                for (int n = 0; n < 2; ++n) acc[a][b][m][n] = (f32x4){0.f, 0.f, 0.f, 0.f};
    bf16x8 At[4][2], B0[2][2], B1[2][2];
    const char* cA = (const char*)(cur.half ? g.A2 : g.A) + (size_t)cur.pm * tstep; const char* cB = (const char*)(cur.half ? g.Bt2 : g.Bt) + (size_t)cur.pn * tstep;
    S.a_ready(cur);
    if constexpr (SP2) {
        PG8_STAGE(PG8_SB(0, 0), cB, voffB); PG8_STAGE(PG8_SB(0, 1), cB + hstep, voffB); PG8_STAGE(PG8_SA(0, 0), cA, voffA); PG8_STAGE(PG8_SA(0, 1), cA + hstep, voffA);
        if (wr == 1) PG8_BAR;
        PG8_WAIT_V(2); PG8_BAR;
        PG8_STAGE(PG8_SB(1, 0), cB + kstep, voffB); PG8_STAGE(PG8_SA(1, 0), cA + kstep, voffA); PG8_STAGE(PG8_SB(1, 1), cB + hstep + kstep, voffB);
        PG8_WAIT_V(6); PG8_BAR;
    } else {
        PG8_STAGE(PG8_SB(0, 0), cB, voffB); PG8_STAGE(PG8_SA(0, 0), cA, voffA); PG8_STAGE(PG8_SB(0, 1), cB + hstep, voffB); PG8_STAGE(PG8_SA(0, 1), cA + hstep, voffA);
        if (wr == 1) PG8_BAR;
        PG8_WAIT_V(4); PG8_BAR;
        PG8_STAGE(PG8_SB(1, 0), cB + kstep, voffB); PG8_STAGE(PG8_SA(1, 0), cA + kstep, voffA); PG8_STAGE(PG8_SB(1, 1), cB + hstep + kstep, voffB);
        PG8_WAIT_V(6); PG8_BAR;
    }
    for (;;) {
        const bool has_next = S.next(ui + 1, nxt);
        const char* nA = has_next ? (const char*)(nxt.half ? g.A2 : g.A) + (size_t)nxt.pm * tstep : cA; const char* nB = has_next ? (const char*)(nxt.half ? g.Bt2 : g.Bt) + (size_t)nxt.pn * tstep : cB;
        for (int t = 0; t < nt; t += 2) {
            const bool last = (t == nt - 2);
            const char* a1 = cA + (size_t)(t + 1) * kstep;
            const char* a2 = last ? nA : cA + (size_t)(t + 2) * kstep; const char* b2 = last ? nB : cB + (size_t)(t + 2) * kstep;
            const char* a3 = a2 + kstep; const char* b3 = b2 + kstep;
            if (last && has_next) S.a_ready(nxt);
            if constexpr (SP2) {
            PG8_LDB(B0, 0, 0); PG8_LDB(B1, 0, 1); PG8_SCHED; PG8_LDA(At, 0, 0); PG8_STAGE(PG8_SA(1, 1), a1 + hstep, voffA);
            PG8_WAIT_V(8); PG8_WAIT_L(0); PG8_BAR; PG8_MMA(0, 0, At, B0); PG8_MMA(0, 1, At, B1); PG8_BAR; PG8_SCHED;
            PG8_LDA(At, 0, 1); PG8_STAGE(PG8_SB(0, 0), b2, voffB); PG8_STAGE(PG8_SB(0, 1), b2 + hstep, voffB); PG8_STAGE(PG8_SA(0, 0), a2, voffA);
            PG8_WAIT_V(8); PG8_WAIT_L(0); PG8_BAR; PG8_MMA(1, 0, At, B0); PG8_MMA(1, 1, At, B1); PG8_BAR; PG8_SCHED;
            PG8_LDB(B0, 1, 0); PG8_LDB(B1, 1, 1); PG8_SCHED; PG8_LDA(At, 1, 0); PG8_STAGE(PG8_SA(0, 1), a2 + hstep, voffA);
            PG8_WAIT_V(8); PG8_WAIT_L(0); PG8_BAR; PG8_MMA(0, 0, At, B0); PG8_MMA(0, 1, At, B1); PG8_BAR; PG8_SCHED;
            PG8_LDA(At, 1, 1); PG8_STAGE(PG8_SB(1, 0), b3, voffB); PG8_STAGE(PG8_SB(1, 1), b3 + hstep, voffB); PG8_STAGE(PG8_SA(1, 0), a3, voffA);
            PG8_WAIT_V(8); PG8_WAIT_L(0); PG8_BAR; PG8_MMA(1, 0, At, B0); PG8_MMA(1, 1, At, B1); PG8_BAR; PG8_SCHED;
            } else {
            PG8_LDB(B0, 0, 0); PG8_SCHED; PG8_LDA(At, 0, 0); PG8_STAGE(PG8_SA(1, 1), a1 + hstep, voffA);
            PG8_WAIT_L(8); PG8_BAR; PG8_WAIT_L(0); PG8_MMA(0, 0, At, B0); PG8_BAR; PG8_SCHED;
            PG8_LDB(B1, 0, 1); PG8_STAGE(PG8_SB(0, 0), b2, voffB);
            PG8_BAR; PG8_WAIT_L(0); PG8_MMA(0, 1, At, B1); PG8_BAR;
            PG8_LDA(At, 0, 1); PG8_STAGE(PG8_SA(0, 0), a2, voffA);
            PG8_BAR; PG8_WAIT_L(0); PG8_MMA(1, 0, At, B0); PG8_BAR; PG8_SCHED;
            PG8_STAGE(PG8_SB(0, 1), b2 + hstep, voffB);
            PG8_WAIT_V(6); PG8_BAR; PG8_MMA(1, 1, At, B1); PG8_BAR;
            PG8_LDB(B0, 1, 0); PG8_SCHED; PG8_LDA(At, 1, 0); PG8_STAGE(PG8_SA(0, 1), a2 + hstep, voffA);
            PG8_WAIT_L(8); PG8_BAR; PG8_WAIT_L(0); PG8_MMA(0, 0, At, B0); PG8_BAR; PG8_SCHED;
            PG8_LDB(B1, 1, 1); PG8_STAGE(PG8_SB(1, 0), b3, voffB);
            PG8_BAR; PG8_WAIT_L(0); PG8_MMA(0, 1, At, B1); PG8_BAR;
            PG8_LDA(At, 1, 1); PG8_STAGE(PG8_SA(1, 0), a3, voffA);
            PG8_BAR; PG8_WAIT_L(0); PG8_MMA(1, 0, At, B0); PG8_BAR; PG8_SCHED;
            PG8_STAGE(PG8_SB(1, 1), b3 + hstep, voffB);
            PG8_WAIT_V(6); PG8_BAR; PG8_MMA(1, 1, At, B1); PG8_BAR;
            }
        }
        if constexpr (ALIGN_EPI) { if (wr == 0) PG8_BAR; }
        const bool keep_acc = (E.midk != 0 && cur.half == 0);
        if constexpr (!Epi::AFTER_DRAIN) { if (keep_acc) E.mid(acc, cur, wr, wc, fr, fq); else E(acc, cur, wr, wc, fr, fq); S.done(cur); }
        if (!has_next) break;
        if (!keep_acc) {
#pragma unroll
        for (int a = 0; a < 2; ++a)
#pragma unroll
            for (int b = 0; b < 2; ++b)
#pragma unroll
                for (int m = 0; m < 4; ++m)
#pragma unroll
                    for (int n = 0; n < 2; ++n) acc[a][b][m][n] = (f32x4){0.f, 0.f, 0.f, 0.f};
        }
        cur = nxt; cA = nA; cB = nB; ++ui;
        if constexpr (ALIGN_EPI) { if (wr == 1) PG8_BAR; }
    }
    PG8_WAIT_V(0);
    if constexpr (!ALIGN_EPI) { if (wr == 0) PG8_BAR; }
    PG8_BAR;
    if constexpr (Epi::AFTER_DRAIN) { E.fused(acc, cur, wr, wc, fr, fq, lds, wid, lane); S.done(cur); }
#undef PG8_SA
#undef PG8_SB
#undef PG8_STAGE
#undef PG8_LDA
#undef PG8_LDB
#undef PG8_MMA
#undef PG8_WAIT_V
#undef PG8_WAIT_L
#undef PG8_BAR
#undef PG8_SCHED
}
}
namespace attn_body {
using bf16=__hip_bfloat16;
using bf16x8=__attribute__((ext_vector_type(8)))short;
using s16x4=__attribute__((ext_vector_type(4)))short;
using f32x16=__attribute__((ext_vector_type(16)))float;
using u32x4=__attribute__((ext_vector_type(4)))unsigned;
constexpr int BATCH=16,NHEAD=8,NKVH=2,SEQ=4096,D=64,DM=NHEAD*D,KP=NKVH*D;
constexpr int NW=8,QBLK=32,QB=QBLK*NW,KVBLK=64,NQB=SEQ/QB;
constexpr int ATTN_PITCH=DM, ATTN_UNIT_ROWS=QB;
__device__ __forceinline__ int crow(int r,int hi){return (r&3)+8*(r>>2)+4*hi;}
#define SBAR() __builtin_amdgcn_sched_barrier(0)
__device__ __forceinline__ void cmask(f32x16&p0,f32x16&p1,int jb,int qrel,int hi){
  const float NEG=-INFINITY; int kb=64*jb+4*hi;
  #pragma unroll
  for(int r=0;r<16;++r){int kv=kb+(r&3)+8*(r>>2); if(kv>qrel)p0[r]=NEG; if(kv+32>qrel)p1[r]=NEG;}
}

constexpr int NSLOT=3, SLOTB=8192;
constexpr int LDS_K=0, LDS_V=NSLOT*SLOTB, LDS_WS=2*NSLOT*SLOTB, LDS_OST=LDS_WS+NW*64*4, LDS_BYTES=LDS_OST+NW*4096;
constexpr float C2=0.125f*1.4426950408889634f;
__device__ __forceinline__ void glds16(const void*gsrc,unsigned lds_dst){unsigned keep;
  asm volatile("s_mov_b32 %0, m0\n\ts_mov_b32 m0, %2\n\ts_nop 0\n\tglobal_load_lds_dwordx4 %1, off\n\ts_mov_b32 m0, %0":"=&s"(keep):"v"(gsrc),"s"(lds_dst):"memory");}
__device__ __forceinline__ float max3f(float a,float b,float c){float r;asm("v_max3_f32 %0, %1, %2, %3":"=v"(r):"v"(a),"v"(b),"v"(c));return r;}
__device__ __forceinline__ float max2f(float a,float b){float r;asm("v_max_f32_e32 %0, %1, %2":"=v"(r):"v"(a),"v"(b));return r;}
__device__ __forceinline__ float fadd_s(float a,float b){float r;asm("v_add_f32_e32 %0, %1, %2":"=v"(r):"v"(a),"v"(b));return r;}
__device__ __forceinline__ float fsub_s(float a,float b){float r;asm("v_sub_f32_e32 %0, %1, %2":"=v"(r):"v"(a),"v"(b));return r;}
typedef float f32x2_t __attribute__((ext_vector_type(2))); typedef __bf16 bf16x2_t __attribute__((ext_vector_type(2)));
__device__ __forceinline__ unsigned cvtpk_s(float lo,float hi){f32x2_t v={lo,hi};bf16x2_t b=__builtin_convertvector(v,bf16x2_t);return __builtin_bit_cast(unsigned,b);}
#define WAIT_BAR(N) asm volatile("s_waitcnt vmcnt(" #N ") lgkmcnt(0)\n\ts_barrier":::"memory")

__device__ __forceinline__ void qkt(f32x16&p0,f32x16&p1,const char*Kslot,const bf16x8*qr,const f32x16&negm,int r32,int hi){
  const char*kb=Kslot+hi*1024+r32*16;
  #pragma unroll
  for(int d0=0;d0<4;++d0){
    const bf16x8 b0=*reinterpret_cast<const bf16x8*>(kb+d0*2048);
    const bf16x8 b1=*reinterpret_cast<const bf16x8*>(kb+d0*2048+512);
    if(d0==0){p0=__builtin_amdgcn_mfma_f32_32x32x16_bf16(b0,qr[0],negm,0,0,0);p1=__builtin_amdgcn_mfma_f32_32x32x16_bf16(b1,qr[0],negm,0,0,0);}
    else{p0=__builtin_amdgcn_mfma_f32_32x32x16_bf16(b0,qr[d0],p0,0,0,0);p1=__builtin_amdgcn_mfma_f32_32x32x16_bf16(b1,qr[d0],p1,0,0,0);}}
}
typedef __attribute__((address_space(3))) const char* lds_cptr;
typedef short v4i16_t __attribute__((ext_vector_type(4)));
__device__ __forceinline__ void kload8(bf16x8*kf,lds_cptr kp){
  kf[0]=*(const __attribute__((address_space(3))) bf16x8*)(kp);      kf[1]=*(const __attribute__((address_space(3))) bf16x8*)(kp+512);
  kf[2]=*(const __attribute__((address_space(3))) bf16x8*)(kp+2048); kf[3]=*(const __attribute__((address_space(3))) bf16x8*)(kp+2560);
  kf[4]=*(const __attribute__((address_space(3))) bf16x8*)(kp+4096); kf[5]=*(const __attribute__((address_space(3))) bf16x8*)(kp+4608);
  kf[6]=*(const __attribute__((address_space(3))) bf16x8*)(kp+6144); kf[7]=*(const __attribute__((address_space(3))) bf16x8*)(kp+6656);
}
__device__ __forceinline__ void kload2(bf16x8*kf,lds_cptr kp,int j){ kf[2*j]=*(const __attribute__((address_space(3))) bf16x8*)(kp+j*2048); kf[2*j+1]=*(const __attribute__((address_space(3))) bf16x8*)(kp+j*2048+512); }
__device__ __forceinline__ s16x4 vtr(lds_cptr p){ return __builtin_bit_cast(s16x4,__builtin_amdgcn_ds_read_tr16_b64_v4i16((__attribute__((address_space(3))) v4i16_t*)p)); }
__device__ __forceinline__ float rowmax(const f32x16&p0,const f32x16&p1){
  float a=max3f(p0[0],p0[1],p1[0]),b=max3f(p0[2],p0[3],p1[1]);a=max3f(a,p1[2],p1[3]);
  #pragma unroll
  for(int r=4;r<16;r+=4){a=max3f(a,p0[r],p0[r+1]);b=max3f(b,p0[r+2],p0[r+3]);a=max3f(a,p1[r],p1[r+1]);b=max3f(b,p1[r+2],p1[r+3]);}
  const float m=max2f(a,b);
  auto rr=__builtin_amdgcn_permlane32_swap(__float_as_uint(m),__float_as_uint(m),false,false);
  return max2f(__uint_as_float(rr[0]),__uint_as_float(rr[1]));
}
__device__ __forceinline__ void pv(f32x16*o,int vb,bf16x8 pa0,bf16x8 pa1,bf16x8 pa2,bf16x8 pa3){
  #pragma unroll
  for(int d0=0;d0<2;++d0){s16x4 lo[4],hi[4];
    #pragma unroll
    for(int ks=0;ks<4;++ks){
      asm volatile("ds_read_b64_tr_b16 %0,%1 offset:%c2":"=&v"(lo[ks]):"v"(vb),"i"(d0*4096+ks*1024):"memory");
      asm volatile("ds_read_b64_tr_b16 %0,%1 offset:%c2":"=&v"(hi[ks]):"v"(vb),"i"(d0*4096+ks*1024+512):"memory");}
    asm volatile("s_waitcnt lgkmcnt(0)":::"memory");SBAR();
    #define PK(k) (bf16x8){lo[k][0],lo[k][1],lo[k][2],lo[k][3],hi[k][0],hi[k][1],hi[k][2],hi[k][3]}
    o[d0]=__builtin_amdgcn_mfma_f32_32x32x16_bf16(pa0,PK(0),o[d0],0,0,0);
    o[d0]=__builtin_amdgcn_mfma_f32_32x32x16_bf16(pa1,PK(1),o[d0],0,0,0);
    o[d0]=__builtin_amdgcn_mfma_f32_32x32x16_bf16(pa2,PK(2),o[d0],0,0,0);
    o[d0]=__builtin_amdgcn_mfma_f32_32x32x16_bf16(pa3,PK(3),o[d0],0,0,0);
    #undef PK
  }
}

#ifndef ATTN_STORE16
#define ATTN_STORE16(p,v) (*(u32x4*)(p)=(v))
#endif
template<int THRL> __device__ __forceinline__ void attn_unit(int b,int h,int qb,const bf16*Q,const bf16*__restrict__ K,const bf16*__restrict__ V,bf16*O,char*shm){
  int tid_o=threadIdx.x; asm volatile("":"+v"(tid_o)); const int tid=tid_o,lane=tid&63,r32=lane&31,hi=lane>>5; const int wid=__builtin_amdgcn_readfirstlane(tid>>6);
  const long rowbase=(long)b*SEQ; const int q0=qb*QB;
  const bf16*Qw=Q+(rowbase+q0+wid*QBLK)*DM+h*D;
  const bf16*Kh=K+rowbase*KP+(h>>2)*D,*Vh=V+rowbase*KP+(h>>2)*D;
  const unsigned lds0=(unsigned)(uintptr_t)shm;
  float*wsf=(float*)(shm+LDS_WS)+wid*64;
  const bf16*ksrc=Kh+(long)lane*KP+wid*8;
  const bf16*vsrc=Vh+(long)(16*(wid&3)+(lane>>2))*KP+(wid>>2)*32+(lane&3)*8;
  const unsigned kdst=lds0+LDS_K+wid*1024, vdst=lds0+LDS_V+wid*1024;
  #define DMA_K(t,slot) glds16(ksrc+(long)(t)*KVBLK*KP,(unsigned)__builtin_amdgcn_readfirstlane(kdst+(slot)))
  #define DMA_V(t,slot) glds16(vsrc+(long)(t)*KVBLK*KP,(unsigned)__builtin_amdgcn_readfirstlane(vdst+(slot)))
  const int vb0=(int)(lds0+LDS_V)+((lane>>4)&1)*32+(lane&3)*8+(4*hi+((lane&15)>>2))*64;
  const char*Kbase=shm+LDS_K; bf16x8 kf[8];
  const lds_cptr shm3=(lds_cptr)shm; const lds_cptr kp0=shm3+LDS_K+hi*1024+r32*16; const lds_cptr vp0=shm3+LDS_V+((lane>>4)&1)*32+(lane&3)*8+(4*hi+((lane&15)>>2))*64;
  const int NT=SEQ/KVBLK;
  DMA_K(0,0);DMA_V(0,0);DMA_K(1,SLOTB);
  bf16x8 qr[4];
  #pragma unroll
  for(int d0=0;d0<4;++d0)qr[d0]=*reinterpret_cast<const bf16x8*>(&Qw[(long)r32*DM+d0*16+hi*8]);
  float mhat=0.f,l_reg=0.f;f32x16 o[2];o[0]=f32x16{};o[1]=f32x16{};f32x16 negm=f32x16{};asm volatile("":"+v"(negm));
  const int qrel=wid*QBLK+r32;
  #define CMASK(P0,P1,t) do{}while(0)
  bool resc=false;
  #define START(P0,P1) do{ const float rm=rowmax(P0,P1); resc=false; \
    { const float dl=rm; mhat=fadd_s(mhat,dl); \
      _Pragma("unroll") for(int r=0;r<16;++r){P0[r]=fsub_s(P0[r],dl);P1[r]=fsub_s(P1[r],dl);} \
      _Pragma("unroll") for(int r=0;r<16;++r)negm[r]=-mhat; asm volatile("":"+v"(negm)); } \
    _Pragma("unroll") for(int r=0;r<16;++r)P0[r]=__builtin_amdgcn_exp2f(P0[r]); }while(0)
  #define RESC() do{ if(resc){ asm volatile("s_waitcnt lgkmcnt(0)":::"memory"); \
      _Pragma("unroll") for(int d_=0;d_<2;++d_) _Pragma("unroll") for(int r=0;r<16;++r)o[d_][r]*=wsf[crow(r,hi)]; } }while(0)
  f32x16 pA0,pA1,pB0,pB1;
  int sl_prev=0,sl_cur=0,sl_next=SLOTB;
  #define ROT() do{sl_prev=sl_cur;sl_cur=sl_next;sl_next=(sl_next==(NSLOT-1)*SLOTB)?0:sl_next+SLOTB;}while(0)
  DMA_K(2,2*SLOTB);
  WAIT_BAR(3);
  qkt(pA0,pA1,Kbase,qr,negm,r32,hi);asm volatile("s_nop 15\n\ts_nop 7":"+v"(pA0),"+v"(pA1));CMASK(pA0,pA1,0);
  START(pA0,pA1);
  _Pragma("unroll") for(int r=0;r<16;++r)pA1[r]=__builtin_amdgcn_exp2f(pA1[r]);
  WAIT_BAR(0);
  DMA_K(3,0);DMA_V(1,SLOTB);
  ROT();
  kload8(kf,kp0+sl_cur);
  WAIT_BAR(2);
  s16x4 vlo[8],vhi[8]; u32x4 pw0,pw1,pw2,pw3;
  #define PKW(P,B) cvtpk_s(P[B],P[B+1])
  #define PAF(k) __builtin_bit_cast(bf16x8,pw##k)
  #define VFR(i) (bf16x8){vlo[i][0],vlo[i][1],vlo[i][2],vlo[i][3],vhi[i][0],vhi[i][1],vhi[i][2],vhi[i][3]}
  #define PIN(x) asm volatile("":"+v"(x))
  #define MX3(a,b,c) __builtin_fmaxf(__builtin_fmaxf((a),(b)),(c))
  #define GAPA(MF,A0,A1,A2,A3,W0,W1,PW) do{ MF; sacc+=A0; sacc+=A1; sacc+=A2; sacc+=A3; PIN(sacc); W0; W1; PIN(PW); SBAR(); }while(0)
  #define EX(v) __builtin_amdgcn_exp2f(v)
  #define GAPB(MF,X,B) do{ MF; X[B]=EX(X[B]); X[B+1]=EX(X[B+1]); X[B+2]=EX(X[B+2]); X[B+3]=EX(X[B+3]); PIN(X); SBAR(); }while(0)
  #define VRD(i) do{ vlo[i]=vtr(vp_+(((i)>>2)*4096+((i)&3)*1024)); vhi[i]=vtr(vp_+(((i)>>2)*4096+((i)&3)*1024+512)); }while(0)
  #define KRD(G,j) do{ if(G){ kload2(kf,kp0+sl_next,j); SBAR(); } }while(0)
  #define STEP(C0,C1,P0,P1,t,GK,GV,GL) do{ SBAR(); \
    const lds_cptr vp_=vp0+sl_prev; \
    VRD(0); SBAR(); float sacc=(P0[0]+P0[1]); \
    GAPA(C0=__builtin_amdgcn_mfma_f32_32x32x16_bf16(kf[0],qr[0],negm,0,0,0), P0[2],P0[3],P0[4],P0[5],     pw0[0]=PKW(P0,0), pw0[1]=PKW(P0,2), pw0); \
    VRD(4); SBAR(); GAPA(C1=__builtin_amdgcn_mfma_f32_32x32x16_bf16(kf[1],qr[0],negm,0,0,0), P0[6],P0[7],P0[8],P0[9],     pw0[2]=PKW(P0,4), pw0[3]=PKW(P0,6), pw0); \
    VRD(1); SBAR(); GAPA(C0=__builtin_amdgcn_mfma_f32_32x32x16_bf16(kf[2],qr[1],C0,0,0,0),   P0[10],P0[11],P0[12],P0[13], pw1[0]=PKW(P0,8), pw1[1]=PKW(P0,10), pw1); \
    VRD(5); SBAR(); GAPA(C1=__builtin_amdgcn_mfma_f32_32x32x16_bf16(kf[3],qr[1],C1,0,0,0),   P0[14],P0[15],P1[0],P1[1],   pw1[2]=PKW(P0,12),pw1[3]=PKW(P0,14), pw1); \
    VRD(2); SBAR(); GAPA(C0=__builtin_amdgcn_mfma_f32_32x32x16_bf16(kf[4],qr[2],C0,0,0,0),   P1[2],P1[3],P1[4],P1[5],     pw2[0]=PKW(P1,0), pw2[1]=PKW(P1,2), pw2); \
    VRD(6); SBAR(); GAPA(C1=__builtin_amdgcn_mfma_f32_32x32x16_bf16(kf[5],qr[2],C1,0,0,0),   P1[6],P1[7],P1[8],P1[9],     pw2[2]=PKW(P1,4), pw2[3]=PKW(P1,6), pw2); \
    VRD(3); SBAR(); GAPA(C0=__builtin_amdgcn_mfma_f32_32x32x16_bf16(kf[6],qr[3],C0,0,0,0),   P1[10],P1[11],P1[12],P1[13], pw3[0]=PKW(P1,8), pw3[1]=PKW(P1,10), pw3); \
    VRD(7); SBAR(); GAPA(C1=__builtin_amdgcn_mfma_f32_32x32x16_bf16(kf[7],qr[3],C1,0,0,0),   P1[14],P1[15],0.f,0.f,       pw3[2]=PKW(P1,12),pw3[3]=PKW(P1,14), pw3); \
    l_reg+=sacc; \
    if(GK){DMA_K((t)+3,sl_cur);} if(GV){DMA_V((t)+1,sl_next);} \
    CMASK(C0,C1,t); \
    { float a=MX3(C0[0],C0[1],C1[0]),b=MX3(C0[2],C0[3],C1[1]); a=MX3(a,C1[2],C1[3]); \
      _Pragma("unroll") for(int r=4;r<16;r+=4){a=MX3(a,C0[r],C0[r+1]);b=MX3(b,C0[r+2],C0[r+3]);a=MX3(a,C1[r],C1[r+1]);b=MX3(b,C1[r+2],C1[r+3]);} \
      float rm=__builtin_fmaxf(a,b); { auto rr=__builtin_amdgcn_permlane32_swap(__float_as_uint(rm),__float_as_uint(rm),false,false); rm=__builtin_fmaxf(__uint_as_float(rr[0]),__uint_as_float(rr[1])); } \
      resc=false; \
      if(__builtin_expect(__any(rm>(float)THRL),0)){ const float dl=__builtin_fmaxf(rm,0.f); mhat+=dl; \
        _Pragma("unroll") for(int r=0;r<16;++r){C0[r]-=dl;C1[r]-=dl;} \
        _Pragma("unroll") for(int r=0;r<16;++r)negm[r]=-mhat; asm volatile("":"+v"(negm)); \
        const float f=__builtin_amdgcn_exp2f(-dl); l_reg*=f; if(hi==0)wsf[r32]=f; resc=true; } } \
    SBAR(); \
    GAPB(o[0]=__builtin_amdgcn_mfma_f32_32x32x16_bf16(PAF(0),VFR(0),o[0],0,0,0), C0,0); \
    GAPB(o[1]=__builtin_amdgcn_mfma_f32_32x32x16_bf16(PAF(0),VFR(4),o[1],0,0,0), C0,4); \
    KRD(GL,0); GAPB(o[0]=__builtin_amdgcn_mfma_f32_32x32x16_bf16(PAF(1),VFR(1),o[0],0,0,0), C0,8); \
    KRD(GL,1); GAPB(o[1]=__builtin_amdgcn_mfma_f32_32x32x16_bf16(PAF(1),VFR(5),o[1],0,0,0), C0,12); \
    KRD(GL,2); GAPB(o[0]=__builtin_amdgcn_mfma_f32_32x32x16_bf16(PAF(2),VFR(2),o[0],0,0,0), C1,0); \
    KRD(GL,3); GAPB(o[1]=__builtin_amdgcn_mfma_f32_32x32x16_bf16(PAF(2),VFR(6),o[1],0,0,0), C1,4); \
    GAPB(o[0]=__builtin_amdgcn_mfma_f32_32x32x16_bf16(PAF(3),VFR(3),o[0],0,0,0), C1,8); \
    GAPB(o[1]=__builtin_amdgcn_mfma_f32_32x32x16_bf16(PAF(3),VFR(7),o[1],0,0,0), C1,12); \
    }while(0)
  int t=1;
  #undef CMASK
  #define CMASK(P0,P1,t) do{}while(0)
  for(;t+5<NT;t+=2){
    STEP(pB0,pB1,pA0,pA1,t,true,true,true);     WAIT_BAR(2); RESC(); ROT();
    STEP(pA0,pA1,pB0,pB1,t+1,true,true,true);   WAIT_BAR(2); RESC(); ROT();
  }
  #undef CMASK
  #define CMASK(P0,P1,t) do{}while(0)
  #define ENDW(tt) do{ if((tt)+3<NT){WAIT_BAR(2);} else if((tt)+2<NT){WAIT_BAR(1);} else {WAIT_BAR(0);} }while(0)
  for(;t+1<NT;t+=2){
    STEP(pB0,pB1,pA0,pA1,t,(t+3<NT),(t+1<NT),(t+1<NT));       ENDW(t);   RESC(); ROT();
    STEP(pA0,pA1,pB0,pB1,t+1,(t+4<NT),(t+2<NT),(t+2<NT));     ENDW(t+1); RESC(); ROT();
  }
  STEP(pB0,pB1,pA0,pA1,NT-1,false,false,false); RESC();
  { float sacc=pB0[0]+pB0[1]; _Pragma("unroll") for(int r=2;r<16;++r)sacc+=pB0[r]; _Pragma("unroll") for(int r=0;r<16;++r)sacc+=pB1[r]; l_reg+=sacc;
    pw0=(u32x4){PKW(pB0,0),PKW(pB0,2),PKW(pB0,4),PKW(pB0,6)};pw1=(u32x4){PKW(pB0,8),PKW(pB0,10),PKW(pB0,12),PKW(pB0,14)};pw2=(u32x4){PKW(pB1,0),PKW(pB1,2),PKW(pB1,4),PKW(pB1,6)};pw3=(u32x4){PKW(pB1,8),PKW(pB1,10),PKW(pB1,12),PKW(pB1,14)};
    SBAR(); pv(o,vb0+sl_cur,PAF(0),PAF(1),PAF(2),PAF(3)); }
  #undef PKW
  #undef PAF
  #undef VFR
  #undef PIN
  #undef MX3
  #undef GAPA
  #undef GAPB
  #undef EX
  #undef VRD
  #undef KRD
  #undef STEP
  #undef ENDW
  {auto rr=__builtin_amdgcn_permlane32_swap(__float_as_uint(l_reg),__float_as_uint(l_reg),false,false);l_reg=__uint_as_float(rr[0])+__uint_as_float(rr[1]);}
  if(hi==0)wsf[32+r32]=l_reg;asm volatile("s_waitcnt lgkmcnt(0)":::"memory");
  float rli[16];
  #pragma unroll
  for(int r=0;r<16;++r)rli[r]=__builtin_amdgcn_rcpf(wsf[32+crow(r,hi)]);
  bf16*Ow=O+(rowbase+q0+wid*QBLK)*DM+h*D;
  { bf16*stg=(bf16*)(shm+LDS_OST)+wid*2048;
    #pragma unroll
    for(int r=0;r<16;++r){const int orow=crow(r,hi);
      #pragma unroll
      for(int d0=0;d0<2;++d0)stg[orow*64+d0*32+r32]=__float2bfloat16(o[d0][r]*rli[r]);}
    asm volatile("s_waitcnt lgkmcnt(0)":::"memory");
    #pragma unroll
    for(int i=0;i<4;++i){const int row=i*8+(lane>>3),ch=lane&7; const u32x4 v=*(const u32x4*)(stg+row*64+ch*8); ATTN_STORE16(Ow+(long)row*DM+ch*8,v);} }
  asm volatile("s_waitcnt lgkmcnt(0)\n\ts_barrier":::"memory");
  #undef DMA_K
  #undef DMA_V
  #undef CMASK
  #undef START
  #undef RESC
  #undef ROT
}
constexpr int ATTN_LDS_BYTES=LDS_BYTES;
struct AttnTensors { const bf16* Q; const bf16* K; const bf16* V; bf16* O; };
struct AttnUnit { int bh; int qb; };
struct StaticOrder {
  int vcu, G;
  __device__ __forceinline__ explicit StaticOrder(int grid,int block):vcu((grid%8==0)?(block%8)*(grid/8)+block/8:block),G(grid){}
  __device__ __forceinline__ bool next(int i,AttnUnit&u)const{ const int idx=i*G+vcu; if(idx>=BATCH*NHEAD*NQB)return false; const int pair=idx/(4*NQB), r=idx%(4*NQB); u.bh=(pair>>1)*NHEAD+(pair&1)*4+r/NQB; u.qb=r%NQB; return true; }
  __device__ __forceinline__ void a_ready(const AttnUnit&)const{}
  __device__ __forceinline__ void done(const AttnUnit&)const{}
};
template<class Sched,int THRL=8> __device__ __forceinline__ void attn_phase(char*lds,const AttnTensors&T,const Sched&S){
  AttnUnit u;
  for(int i=0;S.next(i,u);++i){ S.a_ready(u); attn_unit<THRL>(u.bh/NHEAD,u.bh%NHEAD,u.qb,T.Q,T.K,T.V,T.O,lds); S.done(u); }
}
#undef SBAR
#undef WAIT_BAR
}
#define GAS __attribute__((address_space(1)))
#define LAS __attribute__((address_space(3)))
typedef unsigned short bf16;
typedef unsigned v4u __attribute__((ext_vector_type(4)));
typedef unsigned v2u __attribute__((ext_vector_type(2)));
typedef float f32x4 __attribute__((ext_vector_type(4)));
typedef float f32x2 __attribute__((ext_vector_type(2)));
typedef short bf16x8 __attribute__((ext_vector_type(8)));
typedef bf16x8 bf16x8_u2 __attribute__((aligned(2)));
constexpr int NWAVES = 8, NTHR = 512;
constexpr int LDS_BYTES = 161792;
constexpr int ZS = 4496, ZO = 192;
constexpr int HY_F_OFF = 16 * ZS * 2;
constexpr int HY_RED_OFF = HY_F_OFF + 16384;
constexpr int BARST_OFF = 161280;
constexpr size_t CTL_ZERO_BYTES = 16384;

__device__ __forceinline__ unsigned f2bf(float f) { unsigned u = __builtin_bit_cast(unsigned, f); return (u + 0x7fffu + ((u >> 16) & 1u)) >> 16; }
__device__ __forceinline__ unsigned pk2(float lo, float hi) { return f2bf(lo) | (f2bf(hi) << 16); }
__device__ __forceinline__ float bflo(unsigned w) { return __uint_as_float(w << 16); }
__device__ __forceinline__ float bfhi(unsigned w) { return __uint_as_float(w & 0xffff0000u); }
__device__ __forceinline__ float bf1(bf16 h) { return __uint_as_float((unsigned)h << 16); }
__device__ __forceinline__ float wave_sum(float v) {
#pragma unroll
    for (int o = 1; o < 64; o <<= 1) v += __shfl_xor(v, o);
    return v;
}
__device__ __forceinline__ float sq4v(f32x4 v) { return (v[0] * v[0] + v[1] * v[1]) + (v[2] * v[2] + v[3] * v[3]); }
#define LDS_WAIT() asm volatile("s_waitcnt lgkmcnt(0)" ::: "memory")

#define XB_TMO      128
#define XB_XCNT(j)  (256  + 64 * (j))
#define XB_XSUB(j)  (1280 + 64 * (j))
#define XB_XGEN(j)  (2304 + 64 * (j))
#define XB_TOP      3328
#define XB_TOPGEN   3392
#define XCD_BAR_WORDS 3456
#define XB_SPIN_CAP (1u << 18)

__device__ __forceinline__ unsigned xb_ld(unsigned* p)              { return __hip_atomic_load(p, __ATOMIC_RELAXED, __HIP_MEMORY_SCOPE_AGENT); }
__device__ __forceinline__ unsigned xb_add(unsigned* p, unsigned v) { return __hip_atomic_fetch_add(p, v, __ATOMIC_RELAXED, __HIP_MEMORY_SCOPE_AGENT); }
__device__ __forceinline__ unsigned xb_xcc_id() { return (unsigned)__builtin_amdgcn_s_getreg((3 << 11) | 20) & 0xFu; }
#define XB_SPIN(cond, bar) do { unsigned _sp = 0; while (cond) { __builtin_amdgcn_s_sleep(1); \
    if ((++_sp & 255u) == 0u) { if (xb_ld(&(bar)[XB_TMO])) break; if (_sp > XB_SPIN_CAP) { atomicAdd(&(bar)[XB_TMO], 1u); break; } } } } while (0)

struct XcdBarrier {
    unsigned* bar; unsigned x;
    volatile LAS unsigned* st;
};

__device__ __forceinline__ XcdBarrier xcd_barrier_post(unsigned* bar, volatile LAS unsigned* st) {
    XcdBarrier b; b.bar = bar; b.x = xb_xcc_id(); b.st = st;
    if (threadIdx.x == 0) (void)xb_add(&bar[XB_XCNT(b.x)], 1u);
    return b;
}
__device__ __forceinline__ void xcd_barrier_complete(unsigned* bar, unsigned x, unsigned& nloc, unsigned& nx) {
    const unsigned G = gridDim.x * gridDim.y * gridDim.z;
    unsigned sum, cnt, mine, sp = 0u;
    for (;;) {
        sum = 0u; cnt = 0u; mine = 0u;
#pragma unroll
        for (unsigned j = 0; j < 16; ++j) { const unsigned c = xb_ld(&bar[XB_XCNT(j)]); sum += c; cnt += (c > 0u) ? 1u : 0u; mine = (j == x) ? c : mine; }
        if (sum == G) break;
        __builtin_amdgcn_s_sleep(1);
        if ((++sp & 255u) == 0u) { if (xb_ld(&bar[XB_TMO])) break; if (sp > XB_SPIN_CAP) { atomicAdd(&bar[XB_TMO], 1u); break; } }
    }
    nloc = mine > 0u ? mine : 1u; nx = cnt > 0u ? cnt : 1u;
}

__device__ __forceinline__ void xcd_barrier(const XcdBarrier& b) {
    asm volatile("s_waitcnt vmcnt(0)" ::: "memory");
    __syncthreads();
    if (threadIdx.x == 0) {
        unsigned* bar = b.bar;
        __builtin_amdgcn_s_waitcnt(0);
        unsigned nloc = b.st[0], nx = b.st[1];
        if (nloc == 0u) { xcd_barrier_complete(bar, b.x, nloc, nx); b.st[0] = nloc; b.st[1] = nx; }
        const unsigned old = xb_add(&bar[XB_XSUB(b.x)], 1u);
        const unsigned gen = old / nloc;
        if (old + 1u == (gen + 1u) * nloc) {
            __builtin_amdgcn_fence(__ATOMIC_RELEASE, "agent");
            asm volatile("s_waitcnt vmcnt(0)" ::: "memory");
            const unsigned og = xb_add(&bar[XB_TOP], 1u);
            const unsigned tg = og / nx;
            if (og + 1u == (tg + 1u) * nx) xb_add(&bar[XB_TOPGEN], 1u);
            else XB_SPIN(xb_ld(&bar[XB_TOPGEN]) == tg, bar);
            __builtin_amdgcn_fence(__ATOMIC_ACQUIRE, "agent");
            xb_add(&bar[XB_XGEN(b.x)], 1u);
            asm volatile("s_waitcnt vmcnt(0)" ::: "memory");
        } else {
            XB_SPIN(xb_ld(&bar[XB_XGEN(b.x)]) == gen, bar);
            __builtin_amdgcn_fence(__ATOMIC_ACQUIRE, "agent");
            asm volatile("s_waitcnt vmcnt(0)" ::: "memory");
        }
    }
    __syncthreads();
}

struct Frame { LAS unsigned char* lds; int tid, lane, wave, vcu, G; };

__device__ __forceinline__ void transpose_item(const float* W, int K, int N, bf16* WT, int grp, int stride, int off, const float* g, LAS float* scr, int item, int lane) {
    const int nblk = N / 32, kb = item / nblk, nb = item % nblk, k0 = 64 * kb, n0 = 32 * nb;
#pragma unroll 8
    for (int i = 0; i < 32; ++i) { const int kk = 2 * i + (lane >> 5); float v = W[(size_t)(k0 + kk) * N + n0 + (lane & 31)]; if (g) v *= g[k0 + kk]; scr[kk * 33 + (lane & 31)] = v; }
    LDS_WAIT(); asm volatile("" ::: "memory");
    const int c = lane & 7;
#pragma unroll
    for (int j = 0; j < 4; ++j) { const int n = (lane >> 3) + 8 * j; const LAS float* s = scr + (8 * c) * 33 + n; const int ng = n0 + n, row = (ng / grp) * stride + off + (ng % grp);
        v4u o; o.x = pk2(s[0 * 33], s[1 * 33]); o.y = pk2(s[2 * 33], s[3 * 33]); o.z = pk2(s[4 * 33], s[5 * 33]); o.w = pk2(s[6 * 33], s[7 * 33]);
        *(v4u*)(WT + (size_t)row * K + k0 + 8 * c) = o; }
    LDS_WAIT(); asm volatile("" ::: "memory");
}

struct Args { const float* in[35]; float* out; unsigned char* ws; int step_lo, step_hi; };
#define CAS __attribute__((address_space(4)))
__device__ __forceinline__ const float* karg_in(int k) { CAS const char* ka = (CAS const char*)__builtin_amdgcn_kernarg_segment_ptr(); asm volatile("" : "+s"(ka)); typedef const float* cfp_t; return *(CAS const cfp_t*)(ka + 8 * k); }
__device__ __forceinline__ unsigned char* karg_ws() { CAS const char* ka = (CAS const char*)__builtin_amdgcn_kernarg_segment_ptr(); asm volatile("" : "+s"(ka)); typedef unsigned char* ucp_t; return *(CAS const ucp_t*)(ka + 288); }
__device__ __forceinline__ float* karg_out() { CAS const char* ka = (CAS const char*)__builtin_amdgcn_kernarg_segment_ptr(); asm volatile("" : "+s"(ka)); typedef float* fp_t; return *(CAS const fp_t*)(ka + 280); }
#define IN(k) karg_in(k)

__device__ __forceinline__ void prologue(const Frame& F) {
    unsigned char* ws = karg_ws();
    LAS float* scr = (LAS float*)(F.lds + F.wave * 16384);
    const int gw = F.vcu * NWAVES + F.wave, NGW = F.G * NWAVES, lane = F.lane;
    constexpr int I_G = (DM_ / 64) * (FF / 32), I_D = (FF / 64) * (DM_ / 32), I_IN = (DM_ / 64) * (INC / 32), I_HO = (HYW / 64) * (DM_ / 32), I_O = (DM_ / 64) * (DM_ / 32), I_PP = (PLE / 64) * (DM_ / 32);
    constexpr int NITEMS = 4 * I_G + 2 * I_D + I_IN + 2 * I_HO + 2 * I_O + I_PP;
    const int BIGN = 1 << 30;
    for (int it = gw; it < NITEMS; it += NGW) {
        int r = it;
        if (r < I_G) { transpose_item(IN(4), DM_, FF, (bf16*)(ws + WS_GU1), 128, 256, 0, IN(2), scr, r, lane); continue; } r -= I_G;
        if (r < I_G) { transpose_item(IN(5), DM_, FF, (bf16*)(ws + WS_GU1), 128, 256, 128, IN(2), scr, r, lane); continue; } r -= I_G;
        if (r < I_D) { transpose_item(IN(6), FF, DM_, (bf16*)(ws + WS_D1), BIGN, 0, 0, nullptr, scr, r, lane); continue; } r -= I_D;
        if (r < I_IN) { transpose_item(IN(9), DM_, INC, (bf16*)(ws + WS_IN), BIGN, 0, 0, IN(7), scr, r, lane); continue; } r -= I_IN;
        if (r < I_HO) { transpose_item(IN(23), HYW, DM_, (bf16*)(ws + WS_HYO), BIGN, 0, 0, nullptr, scr, r, lane); continue; } r -= I_HO;
        if (r < I_HO) { transpose_item(IN(24), HYW, DM_, (bf16*)(ws + WS_ATO), BIGN, 0, 0, nullptr, scr, r, lane); continue; } r -= I_HO;
        if (r < I_O) { transpose_item(IN(25), DM_, DM_, (bf16*)(ws + WS_OUT), BIGN, 0, 0, nullptr, scr, r, lane); continue; } r -= I_O;
        if (r < I_G) { transpose_item(IN(28), DM_, FF, (bf16*)(ws + WS_GU2), 128, 256, 0, IN(26), scr, r, lane); continue; } r -= I_G;
        if (r < I_G) { transpose_item(IN(29), DM_, FF, (bf16*)(ws + WS_GU2), 128, 256, 128, IN(26), scr, r, lane); continue; } r -= I_G;
        if (r < I_D) { transpose_item(IN(30), FF, DM_, (bf16*)(ws + WS_D2), BIGN, 0, 0, nullptr, scr, r, lane); continue; } r -= I_D;
        if (r < I_O) { transpose_item(IN(33), DM_, DM_, (bf16*)(ws + WS_PG), BIGN, 0, 0, IN(31), scr, r, lane); continue; } r -= I_O;
        transpose_item(IN(34), PLE, DM_, (bf16*)(ws + WS_PP), BIGN, 0, 0, nullptr, scr, r, lane);
    }
    { const float* x = IN(0); bf16* xb = (bf16*)(ws + WS_XB); float* rs = (float*)(ws + WS_RS);
      for (int row0 = gw; row0 < M; row0 += 2 * NGW) { f32x4 v[2][4];
#pragma unroll
          for (int u = 0; u < 2; ++u) { const int row = (row0 + u * NGW < M) ? row0 + u * NGW : row0; const f32x4* xr = (const f32x4*)(x + (size_t)row * DM_) + lane;
#pragma unroll
              for (int j = 0; j < 4; ++j) v[u][j] = xr[64 * j]; }
#pragma unroll
          for (int u = 0; u < 2; ++u) { const int row = row0 + u * NGW;
              if (row < M) { v2u* o8 = (v2u*)(xb + (size_t)row * DM_) + lane; float ss = 0.f;
#pragma unroll
                  for (int j = 0; j < 4; ++j) { v2u o; o.x = pk2(v[u][j][0], v[u][j][1]); o.y = pk2(v[u][j][2], v[u][j][3]); o8[64 * j] = o;
                      f32x4 xq; xq[0] = bflo(o.x); xq[1] = bfhi(o.x); xq[2] = bflo(o.y); xq[3] = bfhi(o.y); ss += sq4v(xq); }
                  ss = wave_sum(ss); if (lane == 0) rs[row] = 1.0f / sqrtf(ss * (1.0f / DM_) + EPS); } } } }
    { const float *w1 = IN(12), *b1 = IN(13), *f1 = IN(14), *w2 = IN(15), *b2 = IN(16), *f2 = IN(17); float* h2 = (float*)(ws + WS_H2);
      for (int t = gw; t < SEQ; t += NGW) {
          const float tl = (float)t * (1.0f / (float)(SEQ - 1)); const float wv = (float)(2.0 * 3.14159265358979323846 / SEQ) * (float)t;
          float z = 0.f;
          if (lane == 0) z = tl; else if (lane <= 32) { const int bi = (lane - 1) & 15; const float band = 1e-4f + (float)bi * ((15.0f - 1e-4f) / 15.0f); const float ang = wv * band; z = (lane <= 16) ? cosf(ang) : -sinf(ang); }
          float acc = b1[lane];
          for (int i = 0; i < 33; ++i) acc += __shfl(z, i) * w1[i * 64 + lane];
          const float h1 = sinf(f1[lane] * acc);
          float acc2 = b2[lane];
          for (int i = 0; i < 64; ++i) acc2 += __shfl(h1, i) * w2[i * 64 + lane];
          h2[t * 64 + lane] = sinf(f2[lane] * acc2); } }
    { f32x2* rope = (f32x2*)(ws + WS_ROPE);
      for (int idx = (F.vcu * NTHR + F.tid); idx < SEQ * 32; idx += F.G * NTHR) { const int t = idx >> 5, i = idx & 31; const float pos = (i < 16) ? (float)(t >> 6) : (float)(t & 63);
          const float inv = powf(10000.0f, -(float)(2 * (i & 15)) / 32.0f); const float ang = pos * inv; rope[idx] = (f32x2){cosf(ang), sinf(ang)}; } }
}

__device__ __forceinline__ void filter_cols(const Frame& F) {
    unsigned char* ws_ = karg_ws();
    const float* h2 = (const float*)(ws_ + WS_H2); const float* w3 = IN(18); const float* dl = IN(19); bf16* filt = (bf16*)(ws_ + WS_FILT);
    LAS float* sw = (LAS float*)F.lds; LAS float* red = sw + 128;
    for (int pr = blockIdx.x; pr < 2 * HYW; pr += F.G) {
        const int o = pr / HYW, c = pr % HYW, colf = o * 2 * HYW + c, colb = colf + HYW;
        if (F.tid < 128) sw[F.tid] = w3[(size_t)(F.tid & 63) * (4 * HYW) + (F.tid < 64 ? colf : colb)];
        __syncthreads();
        const float df = fabsf(dl[colf]), db = fabsf(dl[colb]);
        float hf[8], hb[8]; float s = 0.f;
#pragma unroll
        for (int i = 0; i < 8; ++i) { const int t = F.tid + NTHR * i; const f32x4* row = (const f32x4*)(h2 + (size_t)t * 64); float af = 0.f, ab = 0.f;
#pragma unroll
            for (int j = 0; j < 16; ++j) { const f32x4 v = row[j]; af += v[0] * sw[4 * j] + v[1] * sw[4 * j + 1] + v[2] * sw[4 * j + 2] + v[3] * sw[4 * j + 3];
                ab += v[0] * sw[64 + 4 * j] + v[1] * sw[64 + 4 * j + 1] + v[2] * sw[64 + 4 * j + 2] + v[3] * sw[64 + 4 * j + 3]; }
            const float tl = (float)t * (1.0f / (float)(SEQ - 1)); hf[i] = af * expf(-tl * df); hb[i] = ab * expf(-tl * db);
            s += (t == 0) ? fabsf(hf[i] + hb[i]) : (fabsf(hf[i]) + fabsf(hb[i]));  asm volatile("" ::: "memory"); }
        s = wave_sum(s); if (F.lane == 0) red[F.wave] = s;
        __syncthreads();
        float tot = 0.f;
#pragma unroll
        for (int w = 0; w < NWAVES; ++w) tot += red[w];
        const float inv = 1.0f / tot; bf16* Fp = filt + (size_t)pr * 8192;
#pragma unroll
        for (int i = 0; i < 8; ++i) { const int t = F.tid + NTHR * i;
            if (t == 0) { Fp[4095] = (bf16)f2bf((hf[i] + hb[i]) * inv); Fp[8191] = 0; }
            else { Fp[4095 - t] = (bf16)f2bf(hf[i] * inv); Fp[4095 + t] = (bf16)f2bf(hb[i] * inv); } }
        __syncthreads();
    }
}

__device__ __forceinline__ void elem_pass(const Frame& F, bf16* xb, const bf16* hb, const float* part, const float* gpost, float scale, float* xout, float* rsout, bool last) {
    const int gw = F.vcu * NWAVES + F.wave, NGW = F.G * NWAVES, lane = F.lane;
    f32x4 g[4];
#pragma unroll
    for (int j = 0; j < 4; ++j) g[j] = ((const f32x4*)gpost)[lane + 64 * j];
    for (int row0 = gw; row0 < M; row0 += 2 * NGW) {
        v2u xw[2][4], hw[2][4]; float pv[2];
#pragma unroll
        for (int u = 0; u < 2; ++u) { const int row = (row0 + u * NGW < M) ? row0 + u * NGW : row0;
            pv[u] = (lane < 16) ? part[(size_t)row * 16 + lane] : 0.f;
            const v2u* xr = (const v2u*)(xb + (size_t)row * DM_) + lane; const v2u* hr = (const v2u*)(hb + (size_t)row * DM_) + lane;
#pragma unroll
            for (int j = 0; j < 4; ++j) { xw[u][j] = xr[64 * j]; hw[u][j] = __builtin_nontemporal_load(hr + 64 * j); } }
#pragma unroll
        for (int u = 0; u < 2; ++u) { const int row = row0 + u * NGW;
            if (row < M) {
                const float rh = scale / sqrtf(wave_sum(pv[u]) * (1.0f / DM_) + EPS);
                v2u* xr = (v2u*)(xb + (size_t)row * DM_) + lane; f32x4* xo = (f32x4*)(xout + (size_t)row * DM_) + lane; float ss = 0.f;
#pragma unroll
                for (int j = 0; j < 4; ++j) { const v2u xv = xw[u][j], h = hw[u][j]; f32x4 x, hv;
                    x[0] = bflo(xv.x); x[1] = bfhi(xv.x); x[2] = bflo(xv.y); x[3] = bfhi(xv.y); hv[0] = bflo(h.x); hv[1] = bfhi(h.x); hv[2] = bflo(h.y); hv[3] = bfhi(h.y);
                    const f32x4 xn = x + hv * g[j] * rh;
                    if (last) __builtin_nontemporal_store(xn, xo + 64 * j);
                    else { v2u o; o.x = pk2(xn[0], xn[1]); o.y = pk2(xn[2], xn[3]); xr[64 * j] = o;
                           f32x4 xq; xq[0] = bflo(o.x); xq[1] = bfhi(o.x); xq[2] = bflo(o.y); xq[3] = bfhi(o.y); ss += sq4v(xq); } }
                if (!last) { ss = wave_sum(ss); if (lane == 0) rsout[row] = 1.0f / sqrtf(ss * (1.0f / DM_) + EPS); }
            } }
    }
}

__device__ __forceinline__ void qk_prep(const Frame& F) {
    unsigned char* ws_ = karg_ws();
    bf16* q = (bf16*)(ws_ + WS_Q); bf16* k = (bf16*)(ws_ + WS_K); const f32x2* rope = (const f32x2*)(ws_ + WS_ROPE); const float *qn = IN(21), *kn = IN(22);
    const int gt = F.vcu * NTHR + F.tid, sub = gt & 7; const int ngrp = F.G * NTHR / 8;
    for (int g0 = gt >> 3; g0 < M * 10; g0 += 4 * ngrp) {
        v4u wv[4];
#pragma unroll
        for (int u = 0; u < 4; ++u) { const int g = (g0 + u * ngrp < M * 10) ? g0 + u * ngrp : g0; const int tok = g / 10, hh = g - tok * 10;
            const bf16* p = (hh < 8 ? q + (size_t)tok * 512 + hh * 64 : k + (size_t)tok * 128 + (hh - 8) * 64) + sub * 8; wv[u] = *(const v4u*)p; }
#pragma unroll
        for (int u = 0; u < 4; ++u) { const int g = g0 + u * ngrp;
            if (g < M * 10) {
                const int tok = g / 10, hh = g - tok * 10; bf16* p = (hh < 8 ? q + (size_t)tok * 512 + hh * 64 : k + (size_t)tok * 128 + (hh - 8) * 64) + sub * 8;
                const v4u w = wv[u]; float x[8] = {bflo(w.x), bfhi(w.x), bflo(w.y), bfhi(w.y), bflo(w.z), bfhi(w.z), bflo(w.w), bfhi(w.w)};
                float ss = 0.f;
#pragma unroll
                for (int e = 0; e < 8; ++e) ss += x[e] * x[e];
                ss += __shfl_xor(ss, 1); ss += __shfl_xor(ss, 2); ss += __shfl_xor(ss, 4);
                const float r = 1.0f / sqrtf(ss * (1.0f / 64.0f) + EPS); const float* gn = (hh < 8 ? qn : kn) + sub * 8; const float sc = (hh < 8) ? QSCALE : 1.0f;
                const f32x2* rp = rope + (size_t)(tok & (SEQ - 1)) * 32 + sub * 4; float y[8];
#pragma unroll
                for (int e = 0; e < 4; ++e) { const float y0 = x[2 * e] * r * gn[2 * e], y1 = x[2 * e + 1] * r * gn[2 * e + 1]; const f32x2 cs = rp[e];
                    y[2 * e] = (y0 * cs.x - y1 * cs.y) * sc; y[2 * e + 1] = (y0 * cs.y + y1 * cs.x) * sc; }
                v4u o; o.x = pk2(y[0], y[1]); o.y = pk2(y[2], y[3]); o.z = pk2(y[4], y[5]); o.w = pk2(y[6], y[7]); *(v4u*)p = o;
            } }
    }
}

__device__ __forceinline__ void hyena_phase(const Frame& F) {
    unsigned char* ws_ = karg_ws();
    const bf16* hyT = (const bf16*)(ws_ + WS_HYT); const bf16* filt = (const bf16*)(ws_ + WS_FILT); bf16* yaT = (bf16*)(ws_ + WS_HB);
    const float *sw = IN(10), *sb = IN(11), *hbias = IN(20);
    LAS bf16* Z = (LAS bf16*)F.lds + ZO; LAS bf16* FL = (LAS bf16*)(F.lds + HY_F_OFF);
    const int tid = F.tid, lane = F.lane, w = F.wave, fr = lane & 15, fq = lane >> 4;
    for (int e = F.tid; e < 16 * 48; e += NTHR) { const int b = e / 48, j = e % 48; const int col = j < 24 ? -192 + 8 * j : 4096 + 8 * (j - 24); *(LAS v4u*)(Z + b * ZS + col) = (v4u){0u, 0u, 0u, 0u}; }
    __syncthreads();
    for (int c = F.vcu; c < HYW; c += F.G) {
        { const bf16* src = hyT + (size_t)c * M; const float w0 = sw[c], w1 = sw[3 * HYW + c], w2 = sw[6 * HYW + c], bb = sb[c];
          int tz = tid; asm volatile("" : "+v"(tz));
#pragma unroll 4
          for (int i = 0; i < 16; ++i) { const int qd = tz + NTHR * i, b = qd >> 9, t0 = (qd & 511) * 8; const bf16* p = src + b * SEQ + t0; const v4u v = *(const v4u*)p;
              float x[10]; { const float xm = bf1(p[-1]), xp = bf1(p[8]); x[0] = t0 > 0 ? xm : 0.f; x[9] = (t0 + 8 < SEQ) ? xp : 0.f; }
              x[1] = bflo(v.x); x[2] = bfhi(v.x); x[3] = bflo(v.y); x[4] = bfhi(v.y); x[5] = bflo(v.z); x[6] = bfhi(v.z); x[7] = bflo(v.w); x[8] = bfhi(v.w);
              float y[8];
#pragma unroll
              for (int e = 0; e < 8; ++e) y[e] = w0 * x[e] + w1 * x[e + 1] + w2 * x[e + 2] + bb;
              v4u o; o.x = pk2(y[0], y[1]); o.y = pk2(y[2], y[3]); o.z = pk2(y[4], y[5]); o.w = pk2(y[6], y[7]); *(LAS v4u*)(Z + b * ZS + t0) = o; } }
        for (int o = 0; o < 2; ++o) {
            { int tf = tid; asm volatile("" : "+v"(tf)); const v4u* fs = (const v4u*)(filt + (size_t)(o * HYW + c) * 8192); ((LAS v4u*)FL)[tf] = fs[tf]; ((LAS v4u*)FL)[tf + NTHR] = fs[tf + NTHR]; }
            __syncthreads();
            f32x4 acc[8][4];
#pragma unroll
            for (int i = 0; i < 8; ++i)
#pragma unroll
                for (int mt = 0; mt < 4; ++mt) acc[i][mt] = (f32x4){0.f, 0.f, 0.f, 0.f};
            const LAS unsigned* FLd = (const LAS unsigned*)FL; const int qbase = 4127 - fr + 8 * fq; const unsigned fsh = (qbase & 1) ? 16u : 0u;
            const LAS bf16* zrow = Z + fr * ZS + 8 * fq;
            bf16x8 af[6];
#define HYC_PIN2(a, b) asm volatile("" : "+v"(wr[a][0]), "+v"(wr[a][1]), "+v"(wr[a][2]), "+v"(wr[a][3]), "+v"(wr[a][4]), "+v"(wr[b][0]), "+v"(wr[b][1]), "+v"(wr[b][2]), "+v"(wr[b][3]), "+v"(wr[b][4]))
#define HYC_FRAG(dd) do { unsigned wr[6][5]; \
                _Pragma("unroll") for (int k = 0; k < 6; ++k) { const LAS unsigned* wp = FLd + ((qbase - 64 * (dd) - 16 * k) >> 1); \
                    _Pragma("unroll") for (int i5 = 0; i5 < 5; ++i5) wr[k][i5] = wp[i5]; } \
                HYC_PIN2(0, 1); HYC_PIN2(2, 3); HYC_PIN2(4, 5); \
                _Pragma("unroll") for (int k = 0; k < 6; ++k) { v4u fv; fv.x = __builtin_amdgcn_alignbit(wr[k][1], wr[k][0], fsh); fv.y = __builtin_amdgcn_alignbit(wr[k][2], wr[k][1], fsh); \
                    fv.z = __builtin_amdgcn_alignbit(wr[k][3], wr[k][2], fsh); fv.w = __builtin_amdgcn_alignbit(wr[k][4], wr[k][3], fsh); af[k] = __builtin_bit_cast(bf16x8, fv); } } while (0)
#define HYC_TB(j) (8 * w + (j))
#define HYC_ZLD2(buf, jp, dpv) do { _Pragma("unroll") for (int t2 = 0; t2 < 2; ++t2) { const int sb_ = (HYC_TB(2 * (jp) + t2) - (dpv)) & 63; const volatile LAS v4u* zp_ = (const volatile LAS v4u*)(zrow + 64 * sb_); \
                    zP[buf][t2][0] = zp_[0]; zP[buf][t2][1] = zp_[4]; } } while (0)
            v4u zP[2][2][2];
            HYC_ZLD2(0, 0, 0);
            for (int dp = 0; dp < 64; ++dp) {
                const int n_ = dp - 8 * w; const int nN = n_ < 0 ? 0 : (n_ > 8 ? 8 : n_);
                { const int d0 = nN > 0 ? dp - 64 : dp; HYC_FRAG(d0); }
#pragma unroll
                for (int jp = 0; jp < 4; ++jp) {
                    if (jp < 3) HYC_ZLD2((jp + 1) & 1, jp + 1, dp); else HYC_ZLD2(0, 0, dp + 1);
#pragma unroll
                    for (int t2 = 0; t2 < 2; ++t2) { const int j = 2 * jp + t2;
                        if (j > 0 && j == nN) HYC_FRAG(dp);
                        const bf16x8 z0 = __builtin_bit_cast(bf16x8, zP[jp & 1][t2][0]), z1 = __builtin_bit_cast(bf16x8, zP[jp & 1][t2][1]);
#pragma unroll
                        for (int mt = 0; mt < 4; ++mt) acc[j][mt] = __builtin_amdgcn_mfma_f32_16x16x32_bf16(af[mt + 2], z0, acc[j][mt], 0, 0, 0);
#pragma unroll
                        for (int mt = 0; mt < 4; ++mt) acc[j][mt] = __builtin_amdgcn_mfma_f32_16x16x32_bf16(af[mt], z1, acc[j][mt], 0, 0, 0); }
                }
            }
#undef HYC_PIN2
#undef HYC_FRAG
#undef HYC_TB
#undef HYC_ZLD2
            int el_ = tid; asm volatile("" : "+v"(el_)); const int efr = el_ & 15, efq = (el_ >> 4) & 3;
            const int gch = (o + 1) * HYW + c; const bf16* gsrc = hyT + (size_t)gch * M + efr * SEQ; const float w0 = sw[gch], w1 = sw[3 * HYW + gch], w2 = sw[6 * HYW + gch], bb = sb[gch], hbv = hbias[o * HYW + c];
#pragma unroll
            for (int i = 0; i < 8; ++i) { int t0i = 64 * (8 * w + i) + 4 * efq; asm volatile("" : "+v"(t0i));
#pragma unroll
                for (int mt = 0; mt < 4; ++mt) { const int t0 = t0i + 16 * mt; const bf16* p = gsrc + t0; const v2u gv = *(const v2u*)p;
                    float x[6]; { const float xm = bf1(p[-1]), xp = bf1(p[4]); x[0] = (t0 & (SEQ - 1)) != 0 ? xm : 0.f; x[5] = ((t0 + 4) & (SEQ - 1)) != 0 ? xp : 0.f; } x[1] = bflo(gv.x); x[2] = bfhi(gv.x); x[3] = bflo(gv.y); x[4] = bfhi(gv.y);
                    const v2u zv = *(const LAS v2u*)(Z + efr * ZS + t0); const float zz[4] = {bflo(zv.x), bfhi(zv.x), bflo(zv.y), bfhi(zv.y)};
#pragma unroll
                    for (int j = 0; j < 4; ++j) { const float gte = w0 * x[j] + w1 * x[j + 1] + w2 * x[j + 2] + bb; acc[i][mt][j] = gte * (acc[i][mt][j] + zz[j] * hbv); }
                    asm volatile("" ::: "memory"); } }
            __syncthreads();
            if (o == 0) {
#pragma unroll
                for (int i = 0; i < 8; ++i) { int t0i = 64 * (8 * w + i) + 4 * efq; asm volatile("" : "+v"(t0i));
#pragma unroll
                    for (int mt = 0; mt < 4; ++mt) { const int t0 = t0i + 16 * mt; v2u ov; ov.x = pk2(acc[i][mt][0], acc[i][mt][1]); ov.y = pk2(acc[i][mt][2], acc[i][mt][3]); *(LAS v2u*)(Z + efr * ZS + t0) = ov; } }
            } else {
#pragma unroll
                for (int i = 0; i < 8; ++i) { int t0i = 64 * (8 * w + i) + 4 * efq; asm volatile("" : "+v"(t0i));
#pragma unroll
                    for (int mt = 0; mt < 4; ++mt) { const int t0 = t0i + 16 * mt; v2u ov; ov.x = pk2(acc[i][mt][0], acc[i][mt][1]); ov.y = pk2(acc[i][mt][2], acc[i][mt][3]);
                        *(v2u*)(yaT + (size_t)c * M + (size_t)efr * SEQ + t0) = ov; }
                    asm volatile("" ::: "memory"); }
            }
        }
        __syncthreads();
    }
}
__device__ __forceinline__ void ya_transpose(const Frame& F) {
    unsigned char* ws_ = karg_ws(); const bf16* yT = (const bf16*)(ws_ + WS_HB); bf16* ya = (bf16*)(ws_ + WS_YA);
    LAS bf16* sT = (LAS bf16*)F.lds;
    const int ch = F.tid & 7, r = F.tid >> 3;
    v4u v[4];
    { const int gi = F.vcu < 8 * 256 ? F.vcu : 0; const int c0 = 64 * (gi & 7), t0 = 256 * (gi >> 3);
#pragma unroll
      for (int k = 0; k < 4; ++k) v[k] = *(const v4u*)(yT + (size_t)(c0 + r) * M + t0 + 64 * k + 8 * ch); }
    for (int gi = F.vcu; gi < 8 * 256; gi += F.G) {
        const int c0 = 64 * (gi & 7), t0 = 256 * (gi >> 3);
        v4u vn[4];
        { const int gn = gi + F.G < 8 * 256 ? gi + F.G : gi; const int cn = 64 * (gn & 7), tn = 256 * (gn >> 3);
#pragma unroll
          for (int k = 0; k < 4; ++k) vn[k] = *(const v4u*)(yT + (size_t)(cn + r) * M + tn + 64 * k + 8 * ch); }
#pragma unroll
        for (int k = 0; k < 4; ++k) { LAS bf16* d = sT + k * (64 * 66) + (8 * ch) * 66 + r; const unsigned w[4] = {v[k].x, v[k].y, v[k].z, v[k].w};
#pragma unroll
            for (int j = 0; j < 4; ++j) { d[(2 * j) * 66] = (bf16)(w[j] & 0xffffu); d[(2 * j + 1) * 66] = (bf16)(w[j] >> 16); } }
        __syncthreads();
#pragma unroll
        for (int k = 0; k < 4; ++k) { const LAS unsigned* sp = (const LAS unsigned*)(sT + k * (64 * 66) + r * 66 + 8 * ch); v4u o; o.x = sp[0]; o.y = sp[1]; o.z = sp[2]; o.w = sp[3];
            *(v4u*)(ya + (size_t)(t0 + 64 * k + r) * HYW + c0 + 8 * ch) = o; }
        __syncthreads();
#pragma unroll
        for (int k = 0; k < 4; ++k) v[k] = vn[k];
    }
}

constexpr int N_STEPS = 15;
#ifndef ONE_LAUNCH
#define ONE_LAUNCH 1
#endif
#ifndef STEP_MASK
#define STEP_MASK 0xFFFF
#endif
__device__ __forceinline__ bool gemm_desc(int st, int q, unsigned char* ws, pg8::Gemm& g, pg8::EpiGen& e) {
    bf16* XB = (bf16*)(ws + WS_XB); bf16* HB = (bf16*)(ws + WS_HB);
    e.ws = ws; e.aux = nullptr; e.O = HB; e.ldc = DM_; e.midk = 0;
    if (q == 0) {
        switch (st) {
        case 1: case 10: g = pg8::Gemm{XB, (const bf16*)(ws + (st == 10 ? WS_GU2 : WS_GU1)), M, 2 * FF, DM_}; e.mode = pg8::EM_SWIGLU; e.O = (bf16*)(ws + WS_ACT); e.ldc = FF; return true;
        case 2: case 11: g = pg8::Gemm{(const bf16*)(ws + WS_ACT), (const bf16*)(ws + (st == 11 ? WS_D2 : WS_D1)), M, DM_, FF}; e.mode = pg8::EM_HSUM; return true;
        case 4: g = pg8::Gemm{(const bf16*)(ws + WS_IN), XB, 3 * HYW, M, DM_}; e.mode = pg8::EM_HYT; e.O = (bf16*)(ws + WS_HYT); e.ldc = M; return true;
        case 7: g = pg8::Gemm{(const bf16*)(ws + WS_YA), (const bf16*)(ws + WS_HYO), M, DM_, HYW, (const bf16*)(ws + WS_YB), (const bf16*)(ws + WS_ATO)}; e.mode = pg8::EM_MERGEA; e.O = (bf16*)(ws + WS_MRG); e.aux = (const bf16*)(ws + WS_SGB); e.midk = 1; return true;
        case 8: g = pg8::Gemm{(const bf16*)(ws + WS_MRG), (const bf16*)(ws + WS_OUT), M, DM_, DM_}; e.mode = pg8::EM_HSUM; return true;
        case 13: g = pg8::Gemm{(const bf16*)(ws + WS_PB), (const bf16*)(ws + WS_PP), M, DM_, PLE}; e.mode = pg8::EM_PLAIN; e.O = (bf16*)(ws + WS_PBUF); return true;
        default: return false;
        }
    } else {
        switch (st) {
        case 4: g = pg8::Gemm{XB, (const bf16*)(ws + WS_IN) + (size_t)3 * HYW * DM_, M, INC - 3 * HYW, DM_}; e.mode = pg8::EM_QKVG; return true;
        case 13: g = pg8::Gemm{XB, (const bf16*)(ws + WS_PG), M, DM_, DM_}; e.mode = pg8::EM_PLEG; e.aux = (const bf16*)(ws + WS_PBUF); return true;
        default: return false;
        }
    }
}
__global__ void __launch_bounds__(NTHR, 2) fwd_kernel(Args args) {
    extern __shared__ __attribute__((aligned(16))) unsigned char lds[];
    const int step_lo = args.step_lo, step_hi = args.step_hi;
    if (threadIdx.x < 2) ((volatile LAS unsigned*)((LAS unsigned char*)lds + BARST_OFF))[threadIdx.x] = 0u;
    __syncthreads();
    const XcdBarrier bar = xcd_barrier_post((unsigned*)karg_ws(), (volatile LAS unsigned*)((LAS unsigned char*)lds + BARST_OFF));
    for (int st = step_lo; st < step_hi; ++st) {
        if (st > step_lo) { if (st == step_lo + 1) cg::this_grid().sync(); else xcd_barrier(bar); }
        if (!((STEP_MASK >> st) & 1)) continue;
        unsigned char* ws = karg_ws();
        int tid_ = threadIdx.x; asm volatile("" : "+v"(tid_));
        Frame F; F.lds = (LAS unsigned char*)lds; F.tid = tid_; F.lane = F.tid & 63; F.wave = __builtin_amdgcn_readfirstlane(F.tid >> 6);
        F.G = gridDim.x; { const int bx = blockIdx.x; F.vcu = (F.G % 8 == 0) ? (bx % 8) * (F.G / 8) + bx / 8 : bx; }
        bf16* XB = (bf16*)(ws + WS_XB); bf16* HB = (bf16*)(ws + WS_HB); float* RS = (float*)(ws + WS_RS); float* PART = (float*)(ws + WS_PART);
        switch (st) {
        case 0: if constexpr (STEP_MASK & 1) prologue(F); break;
        case 1: if constexpr ((STEP_MASK >> 1) & 1) filter_cols(F); break;
        case 5: if constexpr ((STEP_MASK >> 5) & 1) { qk_prep(F); hyena_phase(F); } break;
        case 6: if constexpr ((STEP_MASK >> 6) & 1) { ya_transpose(F); const attn_body::AttnTensors AT{(const attn_body::bf16*)(ws + WS_Q), (const attn_body::bf16*)(ws + WS_K), (const attn_body::bf16*)(ws + WS_V), (attn_body::bf16*)(ws + WS_YB)};
            const attn_body::StaticOrder S((int)F.G, (int)blockIdx.x); attn_body::attn_phase<attn_body::StaticOrder>((char*)lds, AT, S); } break;
        case 12: if constexpr ((STEP_MASK >> 12) & 1) {
            { const f32x4* p4 = (const f32x4*)IN(1); v2u* pb = (v2u*)(ws + WS_PB);
              for (int i = F.vcu * NTHR + F.tid; i < M * PLE / 4; i += F.G * NTHR) { const f32x4 v = p4[i]; v2u o; o.x = pk2(v[0], v[1]); o.y = pk2(v[2], v[3]); pb[i] = o; } } } break;
        default: break;
        }
        if (st == 3 || st == 9 || st == 12 || st == 14) {
            const float* gp = IN(st == 3 ? 3 : st == 9 ? 8 : st == 12 ? 27 : 32);
            elem_pass(F, XB, HB, PART, gp, (st == 3 || st == 12) ? 0.5f : 1.0f, karg_out(), RS, st == 14);
        }
#ifndef NO_GEMM
        for (int q = 0; q < 2; ++q) {
            pg8::Gemm g; pg8::EpiGen e;
            if (!gemm_desc(st, q, ws, g, e)) break;
            pg8::StaticOrder S; S.init(g.M, g.N, F.G, (int)blockIdx.x); S.dual = e.midk;
            pg8::gemm_phase<pg8::EpiGen, pg8::StaticOrder, true, true>(F.lds, g, S, e);
            __syncthreads();
        }
#endif
    }
}

extern "C" void kernel_launch(void* const* d_in, const int* in_sizes, int n_in, void* d_out, int out_size, void* d_ws, size_t ws_size, hipStream_t stream) {
    static int grid = 0;
    if (grid == 0) {
        if (n_in != 35 || ws_size < WS_END) { fprintf(stderr, "kernel_launch: unexpected n_in %d / ws %zu\n", n_in, ws_size); grid = -1; return; }
        int dev = 0, cus = 0, per_cu = 0;
        (void)hipGetDevice(&dev); (void)hipDeviceGetAttribute(&cus, hipDeviceAttributeMultiprocessorCount, dev);
        if (hipFuncSetAttribute((const void*)fwd_kernel, hipFuncAttributeMaxDynamicSharedMemorySize, LDS_BYTES) != hipSuccess) { fprintf(stderr, "kernel_launch: hipFuncSetAttribute failed\n"); grid = -1; return; }
        if (hipOccupancyMaxActiveBlocksPerMultiprocessor(&per_cu, (const void*)fwd_kernel, NTHR, LDS_BYTES) != hipSuccess || per_cu < 1) { fprintf(stderr, "kernel_launch: occupancy query says %d\n", per_cu); per_cu = 1; }
        (void)hipGetLastError();
        grid = cus > 0 ? cus : 256;
    }
    if (grid < 0) return;
    if (hipMemsetAsync(d_ws, 0, CTL_ZERO_BYTES, stream) != hipSuccess) { fprintf(stderr, "kernel_launch: memset of the barrier words failed\n"); return; }
    Args a{};
    for (int i = 0; i < 35; ++i) a.in[i] = (const float*)d_in[i];
    a.out = (float*)d_out; a.ws = (unsigned char*)d_ws;
#if ONE_LAUNCH
    a.step_lo = 0; a.step_hi = N_STEPS;
    void* kargs[] = {&a};
    hipError_t e = hipLaunchCooperativeKernel((const void*)fwd_kernel, dim3(grid), dim3(NTHR), kargs, LDS_BYTES, stream);
    if (e != hipSuccess) fprintf(stderr, "cooperative launch failed: %s (grid %d)\n", hipGetErrorString(e), grid);
#else
    for (int st = 0; st < N_STEPS; ++st) { a.step_lo = st; a.step_hi = st + 1; hipLaunchKernelGGL(fwd_kernel, dim3(grid), dim3(NTHR), LDS_BYTES, stream, a); }
#endif
}
```

```cpp
#include <hip/hip_runtime.h>
#include <hip/hip_cooperative_groups.h>
#include <hip/hip_bf16.h>
#include <cstdio>
#include <cstdint>
#include <cmath>
namespace cg = cooperative_groups;
constexpr int DM_ = 1024, BATCH = 16, SEQ = 4096, M = BATCH * SEQ, FF = 2816, HYW = 512, PLE = 256, INC = 4352;
constexpr float EPS = 1e-6f;
constexpr float QSCALE = 0.125f * 1.4426950408889634f;
constexpr size_t MiB = 1u << 20;
constexpr size_t WS_GU1 = 1 * MiB, WS_D1 = 12 * MiB, WS_IN = 18 * MiB, WS_HYO = 27 * MiB, WS_ATO = 28 * MiB, WS_OUT = 29 * MiB, WS_GU2 = 31 * MiB, WS_D2 = 42 * MiB, WS_PG = 48 * MiB, WS_PP = 50 * MiB;
constexpr size_t WS_FILT = 52 * MiB, WS_H2 = 68 * MiB, WS_ROPE = 69 * MiB, WS_RS = 70 * MiB, WS_PART = 71 * MiB;
constexpr size_t WS_XB = 76 * MiB, WS_HB = 204 * MiB, WS_BIG = 332 * MiB;
constexpr size_t WS_ACT = WS_BIG, WS_HYT = WS_BIG, WS_SGA = 524 * MiB, WS_SGB = 652 * MiB, WS_Q = 780 * MiB, WS_K = 844 * MiB, WS_V = 860 * MiB, WS_YA = 876 * MiB, WS_MRG = WS_BIG;
constexpr size_t WS_PB = WS_BIG, WS_PBUF = 364 * MiB, WS_YB = 940 * MiB, WS_END = 1004 * MiB;
namespace pg8 {
#define PG8_LAS __attribute__((address_space(3)))
typedef unsigned short bf16_t;
typedef short bf16x8 __attribute__((ext_vector_type(8)));
typedef float f32x4 __attribute__((ext_vector_type(4)));
typedef unsigned u32x4 __attribute__((ext_vector_type(4)));
constexpr int BM = 256, BK = 64, HALF = 128, HTB = HALF * BK * 2  , STAGE_BYTES = 8 * HTB, NXCD = 8, WGM = 4;

__host__ __device__ __forceinline__ int lds_byte(int r, int c) { const int st = (r >> 4) * 2 + (c >> 5), rr = r & 15, cc = c & 31, ob = rr * 64 + cc * 2; return st * 1024 + (ob ^ (((ob >> 9) & 1) << 5)); }
__host__ __device__ __forceinline__ void stage_rc(int b, int& R, int& C) { const int st = b / 1024, sb = b % 1024, swz = sb ^ (((sb >> 9) & 1) << 5); R = (st >> 1) * 16 + swz / 64; C = (st & 1) * 32 + (swz % 64) / 2; }
__host__ __device__ __forceinline__ int perm32(int rho) { const int n = rho >> 4, i = rho & 15; return 8 * (i >> 2) + 4 * n + (i & 3); }

struct Unit { int pm, pn, half; };
struct Gemm { const bf16_t* A; const bf16_t* Bt; int M, N, K; const bf16_t* A2; const bf16_t* Bt2; };

struct StaticOrder {
    int nM, nN, nwg, G, c, dual;
    __host__ __device__ void init(int M, int N, int G_, int c_) { nM = M / BM; nN = N / BM; nwg = nM * nN; G = G_; c = c_; dual = 0; }
    __host__ __device__ bool next(int i, Unit& u) const {
        const int ii = dual ? (i >> 1) : i; u.half = dual ? (i & 1) : 0;
        const long L = (long)ii * G + c; if (L >= nwg) return false;
        int wgid = (int)L; { const int q = nwg / NXCD, r = nwg % NXCD, xcd = wgid % NXCD, off = wgid / NXCD; wgid = (xcd < r ? xcd * (q + 1) : r * (q + 1) + (xcd - r) * q) + off; }
        const int nig = WGM * nN, gid = wgid / nig, fm = gid * WGM, gsz = (nM - fm) < WGM ? (nM - fm) : WGM;
        u.pm = fm + ((wgid % nig) % gsz); u.pn = (wgid % nig) / gsz; return true;
    }
    __device__ __forceinline__ void a_ready(const Unit&) const {}
    __device__ __forceinline__ void done(const Unit&) const {}
};

__device__ __forceinline__ unsigned cvt_pk_bf16(float lo, float hi) { unsigned r; asm volatile("v_cvt_pk_bf16_f32 %0, %1, %2" : "=v"(r) : "v"(lo), "v"(hi)); return r; }
typedef float f32x2 __attribute__((ext_vector_type(2)));
enum { EM_SWIGLU = 0, EM_HSUM = 1, EM_HYT = 2, EM_QKVG = 3, EM_MERGEA = 4, EM_MERGEB = 5, EM_PLAIN = 6, EM_PLEG = 7 };
__device__ __forceinline__ void st8(bf16_t* p, f32x4 v0, f32x4 v1) { u32x4 w; w.x = cvt_pk_bf16(v0[0], v0[1]); w.y = cvt_pk_bf16(v0[2], v0[3]); w.z = cvt_pk_bf16(v1[0], v1[1]); w.w = cvt_pk_bf16(v1[2], v1[3]); *(u32x4*)p = w; }
__device__ __forceinline__ void ld8(const bf16_t* p, f32x4& v0, f32x4& v1) { const u32x4 w = *(const u32x4*)p;
    v0[0] = __uint_as_float(w.x << 16); v0[1] = __uint_as_float(w.x & 0xffff0000u); v0[2] = __uint_as_float(w.y << 16); v0[3] = __uint_as_float(w.y & 0xffff0000u);
    v1[0] = __uint_as_float(w.z << 16); v1[1] = __uint_as_float(w.z & 0xffff0000u); v1[2] = __uint_as_float(w.w << 16); v1[3] = __uint_as_float(w.w & 0xffff0000u); }
__device__ __forceinline__ void un8(const u32x4 w, f32x4& v0, f32x4& v1) {
    v0[0] = __uint_as_float(w.x << 16); v0[1] = __uint_as_float(w.x & 0xffff0000u); v0[2] = __uint_as_float(w.y << 16); v0[3] = __uint_as_float(w.y & 0xffff0000u);
    v1[0] = __uint_as_float(w.z << 16); v1[1] = __uint_as_float(w.z & 0xffff0000u); v1[2] = __uint_as_float(w.w << 16); v1[3] = __uint_as_float(w.w & 0xffff0000u); }
__device__ __forceinline__ float sigm(float x) { return __builtin_amdgcn_rcpf(1.0f + __builtin_amdgcn_exp2f(-1.4426950408889634f * x)); }
__device__ __forceinline__ f32x4 sigm4(f32x4 v) { f32x4 o; o[0] = sigm(v[0]); o[1] = sigm(v[1]); o[2] = sigm(v[2]); o[3] = sigm(v[3]); return o; }
__device__ __forceinline__ float sq4(f32x4 v) { return (v[0] * v[0] + v[1] * v[1]) + (v[2] * v[2] + v[3] * v[3]); }
struct EpiGen {
    static constexpr bool PERM = true, AFTER_DRAIN = false;
    int mode; int ldc; int midk;
    bf16_t* O;
    const bf16_t* aux;
    unsigned char* ws;
    __device__ __forceinline__ void mid(f32x4 (&acc)[2][2][4][2], const Unit& u, int wr, int wc, int fr, int fq) const {
        const int row0 = u.pm * BM + wr * 64 + fr, cw = wc * 32 + 8 * fq;
        const bf16_t* sga = (const bf16_t*)(ws + WS_SGA); const bf16_t* sgb = (const bf16_t*)(ws + WS_SGB);
#pragma unroll
        for (int ai = 0; ai < 2; ++ai)
#pragma unroll
        for (int mh = 0; mh < 2; ++mh) {
            u32x4 ga[2][2], gb[2][2];
#pragma unroll
            for (int ml = 0; ml < 2; ++ml)
#pragma unroll
                for (int bj = 0; bj < 2; ++bj) { const size_t off = (size_t)(row0 + ai * HALF + (2 * mh + ml) * 16) * DM_ + u.pn * BM + bj * HALF + cw; ga[ml][bj] = *(const u32x4*)(sga + off); gb[ml][bj] = *(const u32x4*)(sgb + off); }
#pragma unroll
            for (int ml = 0; ml < 2; ++ml)
#pragma unroll
                for (int bj = 0; bj < 2; ++bj) { f32x4 a0, a1, b0, b1; un8(ga[ml][bj], a0, a1); un8(gb[ml][bj], b0, b1); const int m = 2 * mh + ml;
#pragma unroll
                    for (int j = 0; j < 4; ++j) { acc[ai][bj][m][0][j] *= a0[j] * __builtin_amdgcn_rcpf(b0[j]); acc[ai][bj][m][1][j] *= a1[j] * __builtin_amdgcn_rcpf(b1[j]); } }
            asm volatile("" ::: "memory");
        }
    }
    __device__ __forceinline__ void operator()(const f32x4 (&acc)[2][2][4][2], const Unit& u, int wr, int wc, int fr, int fq) const {
        const int row0 = u.pm * BM + wr * 64 + fr, cw = wc * 32 + 8 * fq;
        const float* rs = (const float*)(ws + WS_RS); float* part = (float*)(ws + WS_PART);
        bf16_t *oq = (bf16_t*)(ws + WS_Q), *ok = (bf16_t*)(ws + WS_K), *ov = (bf16_t*)(ws + WS_V), *oga = (bf16_t*)(ws + WS_SGA), *ogb = (bf16_t*)(ws + WS_SGB);
        if (mode == EM_SWIGLU) {
            float r8[2][4];
#pragma unroll
            for (int ai = 0; ai < 2; ++ai)
#pragma unroll
                for (int m = 0; m < 4; ++m) r8[ai][m] = rs[row0 + ai * HALF + m * 16];
#pragma unroll
            for (int ai = 0; ai < 2; ++ai)
#pragma unroll
                for (int m = 0; m < 4; ++m) { const int row = row0 + ai * HALF + m * 16; const float r = r8[ai][m]; f32x4 o[2];
#pragma unroll
                    for (int n = 0; n < 2; ++n) { const f32x4 g = acc[ai][0][m][n] * r, up = acc[ai][1][m][n] * r; o[n] = g * sigm4(g) * up; }
                    st8(O + (size_t)row * FF + u.pn * HALF + cw, o[0], o[1]); }
        } else if (mode == EM_HSUM) {
#pragma unroll
            for (int ai = 0; ai < 2; ++ai)
#pragma unroll
                for (int m = 0; m < 4; ++m) { const int row = row0 + ai * HALF + m * 16; float ss = 0.f;
#pragma unroll
                    for (int bj = 0; bj < 2; ++bj) { const size_t off = (size_t)row * DM_ + u.pn * BM + bj * HALF + cw; const f32x4 v0 = acc[ai][bj][m][0], v1 = acc[ai][bj][m][1];
                        ss += sq4(v0) + sq4(v1); st8(O + off, v0, v1); }
                    ss += __shfl_xor(ss, 16); ss += __shfl_xor(ss, 32);
                    if (fq == 0) part[(size_t)row * 16 + u.pn * 4 + wc] = ss; }
        } else if (mode == EM_HYT) {
            f32x4 rc[2][2];
#pragma unroll
            for (int bj = 0; bj < 2; ++bj) { const int col = u.pn * BM + bj * HALF + cw; rc[bj][0] = *(const f32x4*)(rs + col); rc[bj][1] = *(const f32x4*)(rs + col + 4); }
#pragma unroll
            for (int bj = 0; bj < 2; ++bj) { const int col = u.pn * BM + bj * HALF + cw;
#pragma unroll
                for (int ai = 0; ai < 2; ++ai)
#pragma unroll
                    for (int m = 0; m < 4; ++m) { const int row = row0 + ai * HALF + m * 16; st8(O + (size_t)row * M + col, acc[ai][bj][m][0] * rc[bj][0], acc[ai][bj][m][1] * rc[bj][1]); } }
        } else if (mode == EM_QKVG) {
            const int pn = u.pn;
            float r8[2][4];
#pragma unroll
            for (int ai = 0; ai < 2; ++ai)
#pragma unroll
                for (int m = 0; m < 4; ++m) r8[ai][m] = rs[row0 + ai * HALF + m * 16];
#pragma unroll
            for (int ai = 0; ai < 2; ++ai)
#pragma unroll
                for (int m = 0; m < 4; ++m) { const int row = row0 + ai * HALF + m * 16; const float r = r8[ai][m];
#pragma unroll
                    for (int bj = 0; bj < 2; ++bj) { f32x4 v0 = acc[ai][bj][m][0] * r, v1 = acc[ai][bj][m][1] * r; const int ct = bj * HALF + cw;
                        if (pn < 2) st8(oq + (size_t)row * 512 + pn * BM + ct, v0, v1);
                        else if (pn == 2) st8((bj == 0 ? ok : ov) + (size_t)row * 128 + cw, v0, v1);
                        else if (pn < 7) st8(oga + (size_t)row * 1024 + (pn - 3) * BM + ct, sigm4(v0), sigm4(v1));
                        else st8(ogb + (size_t)row * 1024 + (pn - 7) * BM + ct, sigm4(v0), sigm4(v1)); } }
        } else {
#pragma unroll
            for (int ai = 0; ai < 2; ++ai)
#pragma unroll
            for (int mh = 0; mh < 2; ++mh) {
                u32x4 ga[2][2], pa[2][2]; float rg[2] = {1.f, 1.f};
                if (mode == EM_PLEG) { rg[0] = rs[row0 + ai * HALF + (2 * mh) * 16]; rg[1] = rs[row0 + ai * HALF + (2 * mh + 1) * 16]; }
                if (mode != EM_PLAIN) {
#pragma unroll
                    for (int ml = 0; ml < 2; ++ml)
#pragma unroll
                        for (int bj = 0; bj < 2; ++bj) { const size_t off = (size_t)(row0 + ai * HALF + (2 * mh + ml) * 16) * DM_ + u.pn * BM + bj * HALF + cw; ga[ml][bj] = *(const u32x4*)(aux + off);
                            if (mode == EM_MERGEB) pa[ml][bj] = *(const u32x4*)(O + off); }
                }
#pragma unroll
                for (int ml = 0; ml < 2; ++ml) { const int m = 2 * mh + ml; const int row = row0 + ai * HALF + m * 16; float ss = 0.f; const float r = rg[ml];
#pragma unroll
                    for (int bj = 0; bj < 2; ++bj) { const size_t off = (size_t)row * DM_ + u.pn * BM + bj * HALF + cw; f32x4 v0 = acc[ai][bj][m][0], v1 = acc[ai][bj][m][1];
                        if (mode != EM_PLAIN) { f32x4 g0, g1; un8(ga[ml][bj], g0, g1);
                            if (mode == EM_PLEG) { v0 = sigm4(v0 * r) * g0; v1 = sigm4(v1 * r) * g1; } else { v0 = v0 * g0; v1 = v1 * g1; } }
                        if (mode == EM_MERGEB) { f32x4 p0, p1; un8(pa[ml][bj], p0, p1); v0 = v0 + p0; v1 = v1 + p1; }
                        if (mode == EM_PLEG) ss += sq4(v0) + sq4(v1);
                        st8(O + off, v0, v1); }
                    if (mode == EM_PLEG) { ss += __shfl_xor(ss, 16); ss += __shfl_xor(ss, 32); if (fq == 0) part[(size_t)row * 16 + u.pn * 4 + wc] = ss; } }
                asm volatile("" ::: "memory");
            }
        }
    }
};
template <class Epi, class Sched, bool ALIGN_EPI = false, bool SP2 = false>
__device__ __forceinline__ void gemm_phase(PG8_LAS unsigned char* lds, const Gemm g, const Sched& S, const Epi& E) {
    int tid_o = threadIdx.x; asm volatile("" : "+v"(tid_o)); const int tid = tid_o, wid = __builtin_amdgcn_readfirstlane(tid >> 6), lane = tid & 63, wr = wid >> 2, wc = wid & 3, fr = lane & 15, fq = lane >> 4;
    const int K = g.K, nt = K / BK;
    unsigned voffA[2], voffB[2];
#pragma unroll
    for (int i = 0; i < 2; ++i) { int R, C; stage_rc(tid * 16 + i * 8192, R, C); const int Rb = Epi::PERM ? ((R & ~31) + perm32(R & 31)) : R;
        voffA[i] = (unsigned)(R * K + C) * 2u; voffB[i] = (unsigned)(Rb * K + C) * 2u; }
    const size_t kstep = (size_t)(BK * 2);
    const size_t hstep = (size_t)HALF * K * 2;
    const size_t tstep = 2 * hstep;
    const unsigned ldsw = (unsigned)wid * 1024u;
    const int aoff = lds_byte(wr * 64 + fr, fq * 8), boff = lds_byte(wc * 32 + fr, fq * 8);
#define PG8_SA(b, h) (((b) * 2 + (h)) * HTB)
#define PG8_SB(b, h) ((4 + (b) * 2 + (h)) * HTB)
#define PG8_STAGE(bufoff, gbase, voff) do { _Pragma("unroll") for (int _i = 0; _i < 2; ++_i) \
        __builtin_amdgcn_global_load_lds((const unsigned*)((const char*)(gbase) + (voff)[_i]), (PG8_LAS unsigned*)(lds + (bufoff) + ldsw + _i * 8192), 16, 0, 0); } while (0)
#define PG8_LDA(dst, b, h) do { _Pragma("unroll") for (int m = 0; m < 4; ++m) _Pragma("unroll") for (int k = 0; k < 2; ++k) dst[m][k] = *(const PG8_LAS bf16x8*)(lds + PG8_SA(b, h) + aoff + m * 2048 + k * 1024); } while (0)
#define PG8_LDB(dst, b, h) do { _Pragma("unroll") for (int n = 0; n < 2; ++n) _Pragma("unroll") for (int k = 0; k < 2; ++k) dst[n][k] = *(const PG8_LAS bf16x8*)(lds + PG8_SB(b, h) + boff + n * 2048 + k * 1024); } while (0)
#define PG8_MMA(ai, bj, At, Bt) do { __builtin_amdgcn_s_setprio(1); _Pragma("unroll") for (int m = 0; m < 4; ++m) _Pragma("unroll") for (int n = 0; n < 2; ++n) _Pragma("unroll") for (int k = 0; k < 2; ++k) \
        acc[ai][bj][m][n] = __builtin_amdgcn_mfma_f32_16x16x32_bf16(Bt[n][k], At[m][k], acc[ai][bj][m][n], 0, 0, 0); __builtin_amdgcn_s_setprio(0); } while (0)
#define PG8_WAIT_V(n) asm volatile("s_waitcnt vmcnt(" #n ")" ::: "memory")
#define PG8_WAIT_L(n) asm volatile("s_waitcnt lgkmcnt(" #n ")" ::: "memory")
#define PG8_BAR __builtin_amdgcn_s_barrier()
#define PG8_SCHED __builtin_amdgcn_sched_barrier(0)
    Unit cur, nxt; int ui = 0;
    if (!S.next(0, cur)) return;
    f32x4 acc[2][2][4][2];
#pragma unroll
    for (int a = 0; a < 2; ++a)
#pragma unroll
        for (int b = 0; b < 2; ++b)
#pragma unroll
            for (int m = 0; m < 4; ++m)
#pragma unroll
                for (int n = 0; n < 2; ++n) acc[a][b][m][n] = (f32x4){0.f, 0.f, 0.f, 0.f};
    bf16x8 At[4][2], B0[2][2], B1[2][2];
    const char* cA = (const char*)(cur.half ? g.A2 : g.A) + (size_t)cur.pm * tstep; const char* cB = (const char*)(cur.half ? g.Bt2 : g.Bt) + (size_t)cur.pn * tstep;
    S.a_ready(cur);
    if constexpr (SP2) {
        PG8_STAGE(PG8_SB(0, 0), cB, voffB); PG8_STAGE(PG8_SB(0, 1), cB + hstep, voffB); PG8_STAGE(PG8_SA(0, 0), cA, voffA); PG8_STAGE(PG8_SA(0, 1), cA + hstep, voffA);
        if (wr == 1) PG8_BAR;
        PG8_WAIT_V(2); PG8_BAR;
        PG8_STAGE(PG8_SB(1, 0), cB + kstep, voffB); PG8_STAGE(PG8_SA(1, 0), cA + kstep, voffA); PG8_STAGE(PG8_SB(1, 1), cB + hstep + kstep, voffB);
        PG8_WAIT_V(6); PG8_BAR;
    } else {
        PG8_STAGE(PG8_SB(0, 0), cB, voffB); PG8_STAGE(PG8_SA(0, 0), cA, voffA); PG8_STAGE(PG8_SB(0, 1), cB + hstep, voffB); PG8_STAGE(PG8_SA(0, 1), cA + hstep, voffA);
        if (wr == 1) PG8_BAR;
        PG8_WAIT_V(4); PG8_BAR;
        PG8_STAGE(PG8_SB(1, 0), cB + kstep, voffB); PG8_STAGE(PG8_SA(1, 0), cA + kstep, voffA); PG8_STAGE(PG8_SB(1, 1), cB + hstep + kstep, voffB);
        PG8_WAIT_V(6); PG8_BAR;
    }
    for (;;) {
        const bool has_next = S.next(ui + 1, nxt);
        const char* nA = has_next ? (const char*)(nxt.half ? g.A2 : g.A) + (size_t)nxt.pm * tstep : cA; const char* nB = has_next ? (const char*)(nxt.half ? g.Bt2 : g.Bt) + (size_t)nxt.pn * tstep : cB;
        for (int t = 0; t < nt; t += 2) {
            const bool last = (t == nt - 2);
            const char* a1 = cA + (size_t)(t + 1) * kstep;
            const char* a2 = last ? nA : cA + (size_t)(t + 2) * kstep; const char* b2 = last ? nB : cB + (size_t)(t + 2) * kstep;
            const char* a3 = a2 + kstep; const char* b3 = b2 + kstep;
            if (last && has_next) S.a_ready(nxt);
            if constexpr (SP2) {
            PG8_LDB(B0, 0, 0); PG8_LDB(B1, 0, 1); PG8_SCHED; PG8_LDA(At, 0, 0); PG8_STAGE(PG8_SA(1, 1), a1 + hstep, voffA);
            PG8_WAIT_V(8); PG8_WAIT_L(0); PG8_BAR; PG8_MMA(0, 0, At, B0); PG8_MMA(0, 1, At, B1); PG8_BAR; PG8_SCHED;
            PG8_LDA(At, 0, 1); PG8_STAGE(PG8_SB(0, 0), b2, voffB); PG8_STAGE(PG8_SB(0, 1), b2 + hstep, voffB); PG8_STAGE(PG8_SA(0, 0), a2, voffA);
            PG8_WAIT_V(8); PG8_WAIT_L(0); PG8_BAR; PG8_MMA(1, 0, At, B0); PG8_MMA(1, 1, At, B1); PG8_BAR; PG8_SCHED;
            PG8_LDB(B0, 1, 0); PG8_LDB(B1, 1, 1); PG8_SCHED; PG8_LDA(At, 1, 0); PG8_STAGE(PG8_SA(0, 1), a2 + hstep, voffA);
            PG8_WAIT_V(8); PG8_WAIT_L(0); PG8_BAR; PG8_MMA(0, 0, At, B0); PG8_MMA(0, 1, At, B1); PG8_BAR; PG8_SCHED;
            PG8_LDA(At, 1, 1); PG8_STAGE(PG8_SB(1, 0), b3, voffB); PG8_STAGE(PG8_SB(1, 1), b3 + hstep, voffB); PG8_STAGE(PG8_SA(1, 0), a3, voffA);
            PG8_WAIT_V(8); PG8_WAIT_L(0); PG8_BAR; PG8_MMA(1, 0, At, B0); PG8_MMA(1, 1, At, B1); PG8_BAR; PG8_SCHED;
            } else {
            PG8_LDB(B0, 0, 0); PG8_SCHED; PG8_LDA(At, 0, 0); PG8_STAGE(PG8_SA(1, 1), a1 + hstep, voffA);
            PG8_WAIT_L(8); PG8_BAR; PG8_WAIT_L(0); PG8_MMA(0, 0, At, B0); PG8_BAR; PG8_SCHED;
            PG8_LDB(B1, 0, 1); PG8_STAGE(PG8_SB(0, 0), b2, voffB);
            PG8_BAR; PG8_WAIT_L(0); PG8_MMA(0, 1, At, B1); PG8_BAR;
            PG8_LDA(At, 0, 1); PG8_STAGE(PG8_SA(0, 0), a2, voffA);
            PG8_BAR; PG8_WAIT_L(0); PG8_MMA(1, 0, At, B0); PG8_BAR; PG8_SCHED;
            PG8_STAGE(PG8_SB(0, 1), b2 + hstep, voffB);
            PG8_WAIT_V(6); PG8_BAR; PG8_MMA(1, 1, At, B1); PG8_BAR;
            PG8_LDB(B0, 1, 0); PG8_SCHED; PG8_LDA(At, 1, 0); PG8_STAGE(PG8_SA(0, 1), a2 + hstep, voffA);
            PG8_WAIT_L(8); PG8_BAR; PG8_WAIT_L(0); PG8_MMA(0, 0, At, B0); PG8_BAR; PG8_SCHED;
            PG8_LDB(B1, 1, 1); PG8_STAGE(PG8_SB(1, 0), b3, voffB);
            PG8_BAR; PG8_WAIT_L(0); PG8_MMA(0, 1, At, B1); PG8_BAR;
            PG8_LDA(At, 1, 1); PG8_STAGE(PG8_SA(1, 0), a3, voffA);
            PG8_BAR; PG8_WAIT_L(0); PG8_MMA(1, 0, At, B0); PG8_BAR; PG8_SCHED;
            PG8_STAGE(PG8_SB(1, 1), b3 + hstep, voffB);
            PG8_WAIT_V(6); PG8_BAR; PG8_MMA(1, 1, At, B1); PG8_BAR;
            }
        }
        if constexpr (ALIGN_EPI) { if (wr == 0) PG8_BAR; }
        const bool keep_acc = (E.midk != 0 && cur.half == 0);
        if constexpr (!Epi::AFTER_DRAIN) { if (keep_acc) E.mid(acc, cur, wr, wc, fr, fq); else E(acc, cur, wr, wc, fr, fq); S.done(cur); }
        if (!has_next) break;
        if (!keep_acc) {
#pragma unroll
        for (int a = 0; a < 2; ++a)
#pragma unroll
            for (int b = 0; b < 2; ++b)
#pragma unroll
                for (int m = 0; m < 4; ++m)
#pragma unroll
                    for (int n = 0; n < 2; ++n) acc[a][b][m][n] = (f32x4){0.f, 0.f, 0.f, 0.f};
        }
        cur = nxt; cA = nA; cB = nB; ++ui;
        if constexpr (ALIGN_EPI) { if (wr == 1) PG8_BAR; }
    }
    PG8_WAIT_V(0);
    if constexpr (!ALIGN_EPI) { if (wr == 0) PG8_BAR; }
    PG8_BAR;
    if constexpr (Epi::AFTER_DRAIN) { E.fused(acc, cur, wr, wc, fr, fq, lds, wid, lane); S.done(cur); }
#undef PG8_SA
#undef PG8_SB
#undef PG8_STAGE
#undef PG8_LDA
#undef PG8_LDB
#undef PG8_MMA
#undef PG8_WAIT_V
#undef PG8_WAIT_L
#undef PG8_BAR
#undef PG8_SCHED
}
}
namespace attn_body {
using bf16=__hip_bfloat16;
using bf16x8=__attribute__((ext_vector_type(8)))short;
using s16x4=__attribute__((ext_vector_type(4)))short;
using f32x16=__attribute__((ext_vector_type(16)))float;
using u32x4=__attribute__((ext_vector_type(4)))unsigned;
constexpr int BATCH=16,NHEAD=8,NKVH=2,SEQ=4096,D=64,DM=NHEAD*D,KP=NKVH*D;
constexpr int NW=8,QBLK=32,QB=QBLK*NW,KVBLK=64,NQB=SEQ/QB;
constexpr int ATTN_PITCH=DM, ATTN_UNIT_ROWS=QB;
__device__ __forceinline__ int crow(int r,int hi){return (r&3)+8*(r>>2)+4*hi;}
#define SBAR() __builtin_amdgcn_sched_barrier(0)
__device__ __forceinline__ void cmask(f32x16&p0,f32x16&p1,int jb,int qrel,int hi){
  const float NEG=-INFINITY; int kb=64*jb+4*hi;
  #pragma unroll
  for(int r=0;r<16;++r){int kv=kb+(r&3)+8*(r>>2); if(kv>qrel)p0[r]=NEG; if(kv+32>qrel)p1[r]=NEG;}
}

constexpr int NSLOT=3, SLOTB=8192;
constexpr int LDS_K=0, LDS_V=NSLOT*SLOTB, LDS_WS=2*NSLOT*SLOTB, LDS_OST=LDS_WS+NW*64*4, LDS_BYTES=LDS_OST+NW*4096;
constexpr float C2=0.125f*1.4426950408889634f;
__device__ __forceinline__ void glds16(const void*gsrc,unsigned lds_dst){unsigned keep;
  asm volatile("s_mov_b32 %0, m0\n\ts_mov_b32 m0, %2\n\ts_nop 0\n\tglobal_load_lds_dwordx4 %1, off\n\ts_mov_b32 m0, %0":"=&s"(keep):"v"(gsrc),"s"(lds_dst):"memory");}
__device__ __forceinline__ float max3f(float a,float b,float c){float r;asm("v_max3_f32 %0, %1, %2, %3":"=v"(r):"v"(a),"v"(b),"v"(c));return r;}
__device__ __forceinline__ float max2f(float a,float b){float r;asm("v_max_f32_e32 %0, %1, %2":"=v"(r):"v"(a),"v"(b));return r;}
__device__ __forceinline__ float fadd_s(float a,float b){float r;asm("v_add_f32_e32 %0, %1, %2":"=v"(r):"v"(a),"v"(b));return r;}
__device__ __forceinline__ float fsub_s(float a,float b){float r;asm("v_sub_f32_e32 %0, %1, %2":"=v"(r):"v"(a),"v"(b));return r;}
typedef float f32x2_t __attribute__((ext_vector_type(2))); typedef __bf16 bf16x2_t __attribute__((ext_vector_type(2)));
__device__ __forceinline__ unsigned cvtpk_s(float lo,float hi){f32x2_t v={lo,hi};bf16x2_t b=__builtin_convertvector(v,bf16x2_t);return __builtin_bit_cast(unsigned,b);}
#define WAIT_BAR(N) asm volatile("s_waitcnt vmcnt(" #N ") lgkmcnt(0)\n\ts_barrier":::"memory")

__device__ __forceinline__ void qkt(f32x16&p0,f32x16&p1,const char*Kslot,const bf16x8*qr,const f32x16&negm,int r32,int hi){
  const char*kb=Kslot+hi*1024+r32*16;
  #pragma unroll
  for(int d0=0;d0<4;++d0){
    const bf16x8 b0=*reinterpret_cast<const bf16x8*>(kb+d0*2048);
    const bf16x8 b1=*reinterpret_cast<const bf16x8*>(kb+d0*2048+512);
    if(d0==0){p0=__builtin_amdgcn_mfma_f32_32x32x16_bf16(b0,qr[0],negm,0,0,0);p1=__builtin_amdgcn_mfma_f32_32x32x16_bf16(b1,qr[0],negm,0,0,0);}
    else{p0=__builtin_amdgcn_mfma_f32_32x32x16_bf16(b0,qr[d0],p0,0,0,0);p1=__builtin_amdgcn_mfma_f32_32x32x16_bf16(b1,qr[d0],p1,0,0,0);}}
}
typedef __attribute__((address_space(3))) const char* lds_cptr;
typedef short v4i16_t __attribute__((ext_vector_type(4)));
__device__ __forceinline__ void kload8(bf16x8*kf,lds_cptr kp){
  kf[0]=*(const __attribute__((address_space(3))) bf16x8*)(kp);      kf[1]=*(const __attribute__((address_space(3))) bf16x8*)(kp+512);
  kf[2]=*(const __attribute__((address_space(3))) bf16x8*)(kp+2048); kf[3]=*(const __attribute__((address_space(3))) bf16x8*)(kp+2560);
  kf[4]=*(const __attribute__((address_space(3))) bf16x8*)(kp+4096); kf[5]=*(const __attribute__((address_space(3))) bf16x8*)(kp+4608);
  kf[6]=*(const __attribute__((address_space(3))) bf16x8*)(kp+6144); kf[7]=*(const __attribute__((address_space(3))) bf16x8*)(kp+6656);
}
__device__ __forceinline__ void kload2(bf16x8*kf,lds_cptr kp,int j){ kf[2*j]=*(const __attribute__((address_space(3))) bf16x8*)(kp+j*2048); kf[2*j+1]=*(const __attribute__((address_space(3))) bf16x8*)(kp+j*2048+512); }
__device__ __forceinline__ s16x4 vtr(lds_cptr p){ return __builtin_bit_cast(s16x4,__builtin_amdgcn_ds_read_tr16_b64_v4i16((__attribute__((address_space(3))) v4i16_t*)p)); }
__device__ __forceinline__ float rowmax(const f32x16&p0,const f32x16&p1){
  float a=max3f(p0[0],p0[1],p1[0]),b=max3f(p0[2],p0[3],p1[1]);a=max3f(a,p1[2],p1[3]);
  #pragma unroll
  for(int r=4;r<16;r+=4){a=max3f(a,p0[r],p0[r+1]);b=max3f(b,p0[r+2],p0[r+3]);a=max3f(a,p1[r],p1[r+1]);b=max3f(b,p1[r+2],p1[r+3]);}
  const float m=max2f(a,b);
  auto rr=__builtin_amdgcn_permlane32_swap(__float_as_uint(m),__float_as_uint(m),false,false);
  return max2f(__uint_as_float(rr[0]),__uint_as_float(rr[1]));
}
__device__ __forceinline__ void pv(f32x16*o,int vb,bf16x8 pa0,bf16x8 pa1,bf16x8 pa2,bf16x8 pa3){
  #pragma unroll
  for(int d0=0;d0<2;++d0){s16x4 lo[4],hi[4];
    #pragma unroll
    for(int ks=0;ks<4;++ks){
      asm volatile("ds_read_b64_tr_b16 %0,%1 offset:%c2":"=&v"(lo[ks]):"v"(vb),"i"(d0*4096+ks*1024):"memory");
      asm volatile("ds_read_b64_tr_b16 %0,%1 offset:%c2":"=&v"(hi[ks]):"v"(vb),"i"(d0*4096+ks*1024+512):"memory");}
    asm volatile("s_waitcnt lgkmcnt(0)":::"memory");SBAR();
    #define PK(k) (bf16x8){lo[k][0],lo[k][1],lo[k][2],lo[k][3],hi[k][0],hi[k][1],hi[k][2],hi[k][3]}
    o[d0]=__builtin_amdgcn_mfma_f32_32x32x16_bf16(pa0,PK(0),o[d0],0,0,0);
    o[d0]=__builtin_amdgcn_mfma_f32_32x32x16_bf16(pa1,PK(1),o[d0],0,0,0);
    o[d0]=__builtin_amdgcn_mfma_f32_32x32x16_bf16(pa2,PK(2),o[d0],0,0,0);
    o[d0]=__builtin_amdgcn_mfma_f32_32x32x16_bf16(pa3,PK(3),o[d0],0,0,0);
    #undef PK
  }
}

#ifndef ATTN_STORE16
#define ATTN_STORE16(p,v) (*(u32x4*)(p)=(v))
#endif
template<int THRL> __device__ __forceinline__ void attn_unit(int b,int h,int qb,const bf16*Q,const bf16*__restrict__ K,const bf16*__restrict__ V,bf16*O,char*shm){
  int tid_o=threadIdx.x; asm volatile("":"+v"(tid_o)); const int tid=tid_o,lane=tid&63,r32=lane&31,hi=lane>>5; const int wid=__builtin_amdgcn_readfirstlane(tid>>6);
  const long rowbase=(long)b*SEQ; const int q0=qb*QB;
  const bf16*Qw=Q+(rowbase+q0+wid*QBLK)*DM+h*D;
  const bf16*Kh=K+rowbase*KP+(h>>2)*D,*Vh=V+rowbase*KP+(h>>2)*D;
  const unsigned lds0=(unsigned)(uintptr_t)shm;
  float*wsf=(float*)(shm+LDS_WS)+wid*64;
  const bf16*ksrc=Kh+(long)lane*KP+wid*8;
  const bf16*vsrc=Vh+(long)(16*(wid&3)+(lane>>2))*KP+(wid>>2)*32+(lane&3)*8;
  const unsigned kdst=lds0+LDS_K+wid*1024, vdst=lds0+LDS_V+wid*1024;
  #define DMA_K(t,slot) glds16(ksrc+(long)(t)*KVBLK*KP,(unsigned)__builtin_amdgcn_readfirstlane(kdst+(slot)))
  #define DMA_V(t,slot) glds16(vsrc+(long)(t)*KVBLK*KP,(unsigned)__builtin_amdgcn_readfirstlane(vdst+(slot)))
  const int vb0=(int)(lds0+LDS_V)+((lane>>4)&1)*32+(lane&3)*8+(4*hi+((lane&15)>>2))*64;
  const char*Kbase=shm+LDS_K; bf16x8 kf[8];
  const lds_cptr shm3=(lds_cptr)shm; const lds_cptr kp0=shm3+LDS_K+hi*1024+r32*16; const lds_cptr vp0=shm3+LDS_V+((lane>>4)&1)*32+(lane&3)*8+(4*hi+((lane&15)>>2))*64;
  const int NT=SEQ/KVBLK;
  DMA_K(0,0);DMA_V(0,0);DMA_K(1,SLOTB);
  bf16x8 qr[4];
  #pragma unroll
  for(int d0=0;d0<4;++d0)qr[d0]=*reinterpret_cast<const bf16x8*>(&Qw[(long)r32*DM+d0*16+hi*8]);
  float mhat=0.f,l_reg=0.f;f32x16 o[2];o[0]=f32x16{};o[1]=f32x16{};f32x16 negm=f32x16{};asm volatile("":"+v"(negm));
  const int qrel=wid*QBLK+r32;
  #define CMASK(P0,P1,t) do{}while(0)
  bool resc=false;
  #define START(P0,P1) do{ const float rm=rowmax(P0,P1); resc=false; \
    { const float dl=rm; mhat=fadd_s(mhat,dl); \
      _Pragma("unroll") for(int r=0;r<16;++r){P0[r]=fsub_s(P0[r],dl);P1[r]=fsub_s(P1[r],dl);} \
      _Pragma("unroll") for(int r=0;r<16;++r)negm[r]=-mhat; asm volatile("":"+v"(negm)); } \
    _Pragma("unroll") for(int r=0;r<16;++r)P0[r]=__builtin_amdgcn_exp2f(P0[r]); }while(0)
  #define RESC() do{ if(resc){ asm volatile("s_waitcnt lgkmcnt(0)":::"memory"); \
      _Pragma("unroll") for(int d_=0;d_<2;++d_) _Pragma("unroll") for(int r=0;r<16;++r)o[d_][r]*=wsf[crow(r,hi)]; } }while(0)
  f32x16 pA0,pA1,pB0,pB1;
  int sl_prev=0,sl_cur=0,sl_next=SLOTB;
  #define ROT() do{sl_prev=sl_cur;sl_cur=sl_next;sl_next=(sl_next==(NSLOT-1)*SLOTB)?0:sl_next+SLOTB;}while(0)
  DMA_K(2,2*SLOTB);
  WAIT_BAR(3);
  qkt(pA0,pA1,Kbase,qr,negm,r32,hi);asm volatile("s_nop 15\n\ts_nop 7":"+v"(pA0),"+v"(pA1));CMASK(pA0,pA1,0);
  START(pA0,pA1);
  _Pragma("unroll") for(int r=0;r<16;++r)pA1[r]=__builtin_amdgcn_exp2f(pA1[r]);
  WAIT_BAR(0);
  DMA_K(3,0);DMA_V(1,SLOTB);
  ROT();
  kload8(kf,kp0+sl_cur);
  WAIT_BAR(2);
  s16x4 vlo[8],vhi[8]; u32x4 pw0,pw1,pw2,pw3;
  #define PKW(P,B) cvtpk_s(P[B],P[B+1])
  #define PAF(k) __builtin_bit_cast(bf16x8,pw##k)
  #define VFR(i) (bf16x8){vlo[i][0],vlo[i][1],vlo[i][2],vlo[i][3],vhi[i][0],vhi[i][1],vhi[i][2],vhi[i][3]}
  #define PIN(x) asm volatile("":"+v"(x))
  #define MX3(a,b,c) __builtin_fmaxf(__builtin_fmaxf((a),(b)),(c))
  #define GAPA(MF,A0,A1,A2,A3,W0,W1,PW) do{ MF; sacc+=A0; sacc+=A1; sacc+=A2; sacc+=A3; PIN(sacc); W0; W1; PIN(PW); SBAR(); }while(0)
  #define EX(v) __builtin_amdgcn_exp2f(v)
  #define GAPB(MF,X,B) do{ MF; X[B]=EX(X[B]); X[B+1]=EX(X[B+1]); X[B+2]=EX(X[B+2]); X[B+3]=EX(X[B+3]); PIN(X); SBAR(); }while(0)
  #define VRD(i) do{ vlo[i]=vtr(vp_+(((i)>>2)*4096+((i)&3)*1024)); vhi[i]=vtr(vp_+(((i)>>2)*4096+((i)&3)*1024+512)); }while(0)
  #define KRD(G,j) do{ if(G){ kload2(kf,kp0+sl_next,j); SBAR(); } }while(0)
  #define STEP(C0,C1,P0,P1,t,GK,GV,GL) do{ SBAR(); \
    const lds_cptr vp_=vp0+sl_prev; \
    VRD(0); SBAR(); float sacc=(P0[0]+P0[1]); \
    GAPA(C0=__builtin_amdgcn_mfma_f32_32x32x16_bf16(kf[0],qr[0],negm,0,0,0), P0[2],P0[3],P0[4],P0[5],     pw0[0]=PKW(P0,0), pw0[1]=PKW(P0,2), pw0); \
    VRD(4); SBAR(); GAPA(C1=__builtin_amdgcn_mfma_f32_32x32x16_bf16(kf[1],qr[0],negm,0,0,0), P0[6],P0[7],P0[8],P0[9],     pw0[2]=PKW(P0,4), pw0[3]=PKW(P0,6), pw0); \
    VRD(1); SBAR(); GAPA(C0=__builtin_amdgcn_mfma_f32_32x32x16_bf16(kf[2],qr[1],C0,0,0,0),   P0[10],P0[11],P0[12],P0[13], pw1[0]=PKW(P0,8), pw1[1]=PKW(P0,10), pw1); \
    VRD(5); SBAR(); GAPA(C1=__builtin_amdgcn_mfma_f32_32x32x16_bf16(kf[3],qr[1],C1,0,0,0),   P0[14],P0[15],P1[0],P1[1],   pw1[2]=PKW(P0,12),pw1[3]=PKW(P0,14), pw1); \
    VRD(2); SBAR(); GAPA(C0=__builtin_amdgcn_mfma_f32_32x32x16_bf16(kf[4],qr[2],C0,0,0,0),   P1[2],P1[3],P1[4],P1[5],     pw2[0]=PKW(P1,0), pw2[1]=PKW(P1,2), pw2); \
    VRD(6); SBAR(); GAPA(C1=__builtin_amdgcn_mfma_f32_32x32x16_bf16(kf[5],qr[2],C1,0,0,0),   P1[6],P1[7],P1[8],P1[9],     pw2[2]=PKW(P1,4), pw2[3]=PKW(P1,6), pw2); \
    VRD(3); SBAR(); GAPA(C0=__builtin_amdgcn_mfma_f32_32x32x16_bf16(kf[6],qr[3],C0,0,0,0),   P1[10],P1[11],P1[12],P1[13], pw3[0]=PKW(P1,8), pw3[1]=PKW(P1,10), pw3); \
    VRD(7); SBAR(); GAPA(C1=__builtin_amdgcn_mfma_f32_32x32x16_bf16(kf[7],qr[3],C1,0,0,0),   P1[14],P1[15],0.f,0.f,       pw3[2]=PKW(P1,12),pw3[3]=PKW(P1,14), pw3); \
    l_reg+=sacc; \
    if(GK){DMA_K((t)+3,sl_cur);} if(GV){DMA_V((t)+1,sl_next);} \
    CMASK(C0,C1,t); \
    { float a=MX3(C0[0],C0[1],C1[0]),b=MX3(C0[2],C0[3],C1[1]); a=MX3(a,C1[2],C1[3]); \
      _Pragma("unroll") for(int r=4;r<16;r+=4){a=MX3(a,C0[r],C0[r+1]);b=MX3(b,C0[r+2],C0[r+3]);a=MX3(a,C1[r],C1[r+1]);b=MX3(b,C1[r+2],C1[r+3]);} \
      float rm=__builtin_fmaxf(a,b); { auto rr=__builtin_amdgcn_permlane32_swap(__float_as_uint(rm),__float_as_uint(rm),false,false); rm=__builtin_fmaxf(__uint_as_float(rr[0]),__uint_as_float(rr[1])); } \
      resc=false; \
      if(__builtin_expect(__any(rm>(float)THRL),0)){ const float dl=__builtin_fmaxf(rm,0.f); mhat+=dl; \
        _Pragma("unroll") for(int r=0;r<16;++r){C0[r]-=dl;C1[r]-=dl;} \
        _Pragma("unroll") for(int r=0;r<16;++r)negm[r]=-mhat; asm volatile("":"+v"(negm)); \
        const float f=__builtin_amdgcn_exp2f(-dl); l_reg*=f; if(hi==0)wsf[r32]=f; resc=true; } } \
    SBAR(); \
    GAPB(o[0]=__builtin_amdgcn_mfma_f32_32x32x16_bf16(PAF(0),VFR(0),o[0],0,0,0), C0,0); \
    GAPB(o[1]=__builtin_amdgcn_mfma_f32_32x32x16_bf16(PAF(0),VFR(4),o[1],0,0,0), C0,4); \
    KRD(GL,0); GAPB(o[0]=__builtin_amdgcn_mfma_f32_32x32x16_bf16(PAF(1),VFR(1),o[0],0,0,0), C0,8); \
    KRD(GL,1); GAPB(o[1]=__builtin_amdgcn_mfma_f32_32x32x16_bf16(PAF(1),VFR(5),o[1],0,0,0), C0,12); \
    KRD(GL,2); GAPB(o[0]=__builtin_amdgcn_mfma_f32_32x32x16_bf16(PAF(2),VFR(2),o[0],0,0,0), C1,0); \
    KRD(GL,3); GAPB(o[1]=__builtin_amdgcn_mfma_f32_32x32x16_bf16(PAF(2),VFR(6),o[1],0,0,0), C1,4); \
    GAPB(o[0]=__builtin_amdgcn_mfma_f32_32x32x16_bf16(PAF(3),VFR(3),o[0],0,0,0), C1,8); \
    GAPB(o[1]=__builtin_amdgcn_mfma_f32_32x32x16_bf16(PAF(3),VFR(7),o[1],0,0,0), C1,12); \
    }while(0)
  int t=1;
  #undef CMASK
  #define CMASK(P0,P1,t) do{}while(0)
  for(;t+5<NT;t+=2){
    STEP(pB0,pB1,pA0,pA1,t,true,true,true);     WAIT_BAR(2); RESC(); ROT();
    STEP(pA0,pA1,pB0,pB1,t+1,true,true,true);   WAIT_BAR(2); RESC(); ROT();
  }
  #undef CMASK
  #define CMASK(P0,P1,t) do{}while(0)
  #define ENDW(tt) do{ if((tt)+3<NT){WAIT_BAR(2);} else if((tt)+2<NT){WAIT_BAR(1);} else {WAIT_BAR(0);} }while(0)
  for(;t+1<NT;t+=2){
    STEP(pB0,pB1,pA0,pA1,t,(t+3<NT),(t+1<NT),(t+1<NT));       ENDW(t);   RESC(); ROT();
    STEP(pA0,pA1,pB0,pB1,t+1,(t+4<NT),(t+2<NT),(t+2<NT));     ENDW(t+1); RESC(); ROT();
  }
  STEP(pB0,pB1,pA0,pA1,NT-1,false,false,false); RESC();
  { float sacc=pB0[0]+pB0[1]; _Pragma("unroll") for(int r=2;r<16;++r)sacc+=pB0[r]; _Pragma("unroll") for(int r=0;r<16;++r)sacc+=pB1[r]; l_reg+=sacc;
    pw0=(u32x4){PKW(pB0,0),PKW(pB0,2),PKW(pB0,4),PKW(pB0,6)};pw1=(u32x4){PKW(pB0,8),PKW(pB0,10),PKW(pB0,12),PKW(pB0,14)};pw2=(u32x4){PKW(pB1,0),PKW(pB1,2),PKW(pB1,4),PKW(pB1,6)};pw3=(u32x4){PKW(pB1,8),PKW(pB1,10),PKW(pB1,12),PKW(pB1,14)};
    SBAR(); pv(o,vb0+sl_cur,PAF(0),PAF(1),PAF(2),PAF(3)); }
  #undef PKW
  #undef PAF
  #undef VFR
  #undef PIN
  #undef MX3
  #undef GAPA
  #undef GAPB
  #undef EX
  #undef VRD
  #undef KRD
  #undef STEP
  #undef ENDW
  {auto rr=__builtin_amdgcn_permlane32_swap(__float_as_uint(l_reg),__float_as_uint(l_reg),false,false);l_reg=__uint_as_float(rr[0])+__uint_as_float(rr[1]);}
  if(hi==0)wsf[32+r32]=l_reg;asm volatile("s_waitcnt lgkmcnt(0)":::"memory");
  float rli[16];
  #pragma unroll
  for(int r=0;r<16;++r)rli[r]=__builtin_amdgcn_rcpf(wsf[32+crow(r,hi)]);
  bf16*Ow=O+(rowbase+q0+wid*QBLK)*DM+h*D;
  { bf16*stg=(bf16*)(shm+LDS_OST)+wid*2048;
    #pragma unroll
    for(int r=0;r<16;++r){const int orow=crow(r,hi);
      #pragma unroll
      for(int d0=0;d0<2;++d0)stg[orow*64+d0*32+r32]=__float2bfloat16(o[d0][r]*rli[r]);}
    asm volatile("s_waitcnt lgkmcnt(0)":::"memory");
    #pragma unroll
    for(int i=0;i<4;++i){const int row=i*8+(lane>>3),ch=lane&7; const u32x4 v=*(const u32x4*)(stg+row*64+ch*8); ATTN_STORE16(Ow+(long)row*DM+ch*8,v);} }
  asm volatile("s_waitcnt lgkmcnt(0)\n\ts_barrier":::"memory");
  #undef DMA_K
  #undef DMA_V
  #undef CMASK
  #undef START
  #undef RESC
  #undef ROT
}
constexpr int ATTN_LDS_BYTES=LDS_BYTES;
struct AttnTensors { const bf16* Q; const bf16* K; const bf16* V; bf16* O; };
struct AttnUnit { int bh; int qb; };
struct StaticOrder {
  int vcu, G;
  __device__ __forceinline__ explicit StaticOrder(int grid,int block):vcu((grid%8==0)?(block%8)*(grid/8)+block/8:block),G(grid){}
  __device__ __forceinline__ bool next(int i,AttnUnit&u)const{ const int idx=i*G+vcu; if(idx>=BATCH*NHEAD*NQB)return false; const int pair=idx/(4*NQB), r=idx%(4*NQB); u.bh=(pair>>1)*NHEAD+(pair&1)*4+r/NQB; u.qb=r%NQB; return true; }
  __device__ __forceinline__ void a_ready(const AttnUnit&)const{}
  __device__ __forceinline__ void done(const AttnUnit&)const{}
};
template<class Sched,int THRL=8> __device__ __forceinline__ void attn_phase(char*lds,const AttnTensors&T,const Sched&S){
  AttnUnit u;
  for(int i=0;S.next(i,u);++i){ S.a_ready(u); attn_unit<THRL>(u.bh/NHEAD,u.bh%NHEAD,u.qb,T.Q,T.K,T.V,T.O,lds); S.done(u); }
}
#undef SBAR
#undef WAIT_BAR
}
#define GAS __attribute__((address_space(1)))
#define LAS __attribute__((address_space(3)))
typedef unsigned short bf16;
typedef unsigned v4u __attribute__((ext_vector_type(4)));
typedef unsigned v2u __attribute__((ext_vector_type(2)));
typedef float f32x4 __attribute__((ext_vector_type(4)));
typedef float f32x2 __attribute__((ext_vector_type(2)));
typedef short bf16x8 __attribute__((ext_vector_type(8)));
typedef bf16x8 bf16x8_u2 __attribute__((aligned(2)));
constexpr int NWAVES = 8, NTHR = 512;
constexpr int LDS_BYTES = 161792;
constexpr int ZS = 4496, ZO = 192;
constexpr int HY_F_OFF = 16 * ZS * 2;
constexpr int HY_RED_OFF = HY_F_OFF + 16384;
constexpr int BARST_OFF = 161280;
constexpr size_t CTL_ZERO_BYTES = 16384;

__device__ __forceinline__ unsigned f2bf(float f) { unsigned u = __builtin_bit_cast(unsigned, f); return (u + 0x7fffu + ((u >> 16) & 1u)) >> 16; }
__device__ __forceinline__ unsigned pk2(float lo, float hi) { return f2bf(lo) | (f2bf(hi) << 16); }
__device__ __forceinline__ float bflo(unsigned w) { return __uint_as_float(w << 16); }
__device__ __forceinline__ float bfhi(unsigned w) { return __uint_as_float(w & 0xffff0000u); }
__device__ __forceinline__ float bf1(bf16 h) { return __uint_as_float((unsigned)h << 16); }
__device__ __forceinline__ float wave_sum(float v) {
#pragma unroll
    for (int o = 1; o < 64; o <<= 1) v += __shfl_xor(v, o);
    return v;
}
__device__ __forceinline__ float sq4v(f32x4 v) { return (v[0] * v[0] + v[1] * v[1]) + (v[2] * v[2] + v[3] * v[3]); }
#define LDS_WAIT() asm volatile("s_waitcnt lgkmcnt(0)" ::: "memory")

#define XB_TMO      128
#define XB_XCNT(j)  (256  + 64 * (j))
#define XB_XSUB(j)  (1280 + 64 * (j))
#define XB_XGEN(j)  (2304 + 64 * (j))
#define XB_TOP      3328
#define XB_TOPGEN   3392
#define XCD_BAR_WORDS 3456
#define XB_SPIN_CAP (1u << 18)

__device__ __forceinline__ unsigned xb_ld(unsigned* p)              { return __hip_atomic_load(p, __ATOMIC_RELAXED, __HIP_MEMORY_SCOPE_AGENT); }
__device__ __forceinline__ unsigned xb_add(unsigned* p, unsigned v) { return __hip_atomic_fetch_add(p, v, __ATOMIC_RELAXED, __HIP_MEMORY_SCOPE_AGENT); }
__device__ __forceinline__ unsigned xb_xcc_id() { return (unsigned)__builtin_amdgcn_s_getreg((3 << 11) | 20) & 0xFu; }
#define XB_SPIN(cond, bar) do { unsigned _sp = 0; while (cond) { __builtin_amdgcn_s_sleep(1); \
    if ((++_sp & 255u) == 0u) { if (xb_ld(&(bar)[XB_TMO])) break; if (_sp > XB_SPIN_CAP) { atomicAdd(&(bar)[XB_TMO], 1u); break; } } } } while (0)

struct XcdBarrier {
    unsigned* bar; unsigned x;
    volatile LAS unsigned* st;
};

__device__ __forceinline__ XcdBarrier xcd_barrier_post(unsigned* bar, volatile LAS unsigned* st) {
    XcdBarrier b; b.bar = bar; b.x = xb_xcc_id(); b.st = st;
    if (threadIdx.x == 0) (void)xb_add(&bar[XB_XCNT(b.x)], 1u);
    return b;
}
__device__ __forceinline__ void xcd_barrier_complete(unsigned* bar, unsigned x, unsigned& nloc, unsigned& nx) {
    const unsigned G = gridDim.x * gridDim.y * gridDim.z;
    unsigned sum, cnt, mine, sp = 0u;
    for (;;) {
        sum = 0u; cnt = 0u; mine = 0u;
#pragma unroll
        for (unsigned j = 0; j < 16; ++j) { const unsigned c = xb_ld(&bar[XB_XCNT(j)]); sum += c; cnt += (c > 0u) ? 1u : 0u; mine = (j == x) ? c : mine; }
        if (sum == G) break;
        __builtin_amdgcn_s_sleep(1);
        if ((++sp & 255u) == 0u) { if (xb_ld(&bar[XB_TMO])) break; if (sp > XB_SPIN_CAP) { atomicAdd(&bar[XB_TMO], 1u); break; } }
    }
    nloc = mine > 0u ? mine : 1u; nx = cnt > 0u ? cnt : 1u;
}

__device__ __forceinline__ void xcd_barrier(const XcdBarrier& b) {
    asm volatile("s_waitcnt vmcnt(0)" ::: "memory");
    __syncthreads();
    if (threadIdx.x == 0) {
        unsigned* bar = b.bar;
        __builtin_amdgcn_s_waitcnt(0);
        unsigned nloc = b.st[0], nx = b.st[1];
        if (nloc == 0u) { xcd_barrier_complete(bar, b.x, nloc, nx); b.st[0] = nloc; b.st[1] = nx; }
        const unsigned old = xb_add(&bar[XB_XSUB(b.x)], 1u);
        const unsigned gen = old / nloc;
        if (old + 1u == (gen + 1u) * nloc) {
            __builtin_amdgcn_fence(__ATOMIC_RELEASE, "agent");
            asm volatile("s_waitcnt vmcnt(0)" ::: "memory");
            const unsigned og = xb_add(&bar[XB_TOP], 1u);
            const unsigned tg = og / nx;
            if (og + 1u == (tg + 1u) * nx) xb_add(&bar[XB_TOPGEN], 1u);
            else XB_SPIN(xb_ld(&bar[XB_TOPGEN]) == tg, bar);
            __builtin_amdgcn_fence(__ATOMIC_ACQUIRE, "agent");
            xb_add(&bar[XB_XGEN(b.x)], 1u);
            asm volatile("s_waitcnt vmcnt(0)" ::: "memory");
        } else {
            XB_SPIN(xb_ld(&bar[XB_XGEN(b.x)]) == gen, bar);
            __builtin_amdgcn_fence(__ATOMIC_ACQUIRE, "agent");
            asm volatile("s_waitcnt vmcnt(0)" ::: "memory");
        }
    }
    __syncthreads();
}

struct Frame { LAS unsigned char* lds; int tid, lane, wave, vcu, G; };

__device__ __forceinline__ void transpose_item(const float* W, int K, int N, bf16* WT, int grp, int stride, int off, const float* g, LAS float* scr, int item, int lane) {
    const int nblk = N / 32, kb = item / nblk, nb = item % nblk, k0 = 64 * kb, n0 = 32 * nb;
#pragma unroll 8
    for (int i = 0; i < 32; ++i) { const int kk = 2 * i + (lane >> 5); float v = W[(size_t)(k0 + kk) * N + n0 + (lane & 31)]; if (g) v *= g[k0 + kk]; scr[kk * 33 + (lane & 31)] = v; }
    LDS_WAIT(); asm volatile("" ::: "memory");
    const int c = lane & 7;
#pragma unroll
    for (int j = 0; j < 4; ++j) { const int n = (lane >> 3) + 8 * j; const LAS float* s = scr + (8 * c) * 33 + n; const int ng = n0 + n, row = (ng / grp) * stride + off + (ng % grp);
        v4u o; o.x = pk2(s[0 * 33], s[1 * 33]); o.y = pk2(s[2 * 33], s[3 * 33]); o.z = pk2(s[4 * 33], s[5 * 33]); o.w = pk2(s[6 * 33], s[7 * 33]);
        *(v4u*)(WT + (size_t)row * K + k0 + 8 * c) = o; }
    LDS_WAIT(); asm volatile("" ::: "memory");
}

struct Args { const float* in[35]; float* out; unsigned char* ws; int step_lo, step_hi; };
#define CAS __attribute__((address_space(4)))
__device__ __forceinline__ const float* karg_in(int k) { CAS const char* ka = (CAS const char*)__builtin_amdgcn_kernarg_segment_ptr(); asm volatile("" : "+s"(ka)); typedef const float* cfp_t; return *(CAS const cfp_t*)(ka + 8 * k); }
__device__ __forceinline__ unsigned char* karg_ws() { CAS const char* ka = (CAS const char*)__builtin_amdgcn_kernarg_segment_ptr(); asm volatile("" : "+s"(ka)); typedef unsigned char* ucp_t; return *(CAS const ucp_t*)(ka + 288); }
__device__ __forceinline__ float* karg_out() { CAS const char* ka = (CAS const char*)__builtin_amdgcn_kernarg_segment_ptr(); asm volatile("" : "+s"(ka)); typedef float* fp_t; return *(CAS const fp_t*)(ka + 280); }
#define IN(k) karg_in(k)

__device__ __forceinline__ void prologue(const Frame& F) {
    unsigned char* ws = karg_ws();
    LAS float* scr = (LAS float*)(F.lds + F.wave * 16384);
    const int gw = F.vcu * NWAVES + F.wave, NGW = F.G * NWAVES, lane = F.lane;
    constexpr int I_G = (DM_ / 64) * (FF / 32), I_D = (FF / 64) * (DM_ / 32), I_IN = (DM_ / 64) * (INC / 32), I_HO = (HYW / 64) * (DM_ / 32), I_O = (DM_ / 64) * (DM_ / 32), I_PP = (PLE / 64) * (DM_ / 32);
    constexpr int NITEMS = 4 * I_G + 2 * I_D + I_IN + 2 * I_HO + 2 * I_O + I_PP;
    const int BIGN = 1 << 30;
    for (int it = gw; it < NITEMS; it += NGW) {
        int r = it;
        if (r < I_G) { transpose_item(IN(4), DM_, FF, (bf16*)(ws + WS_GU1), 128, 256, 0, IN(2), scr, r, lane); continue; } r -= I_G;
        if (r < I_G) { transpose_item(IN(5), DM_, FF, (bf16*)(ws + WS_GU1), 128, 256, 128, IN(2), scr, r, lane); continue; } r -= I_G;
        if (r < I_D) { transpose_item(IN(6), FF, DM_, (bf16*)(ws + WS_D1), BIGN, 0, 0, nullptr, scr, r, lane); continue; } r -= I_D;
        if (r < I_IN) { transpose_item(IN(9), DM_, INC, (bf16*)(ws + WS_IN), BIGN, 0, 0, IN(7), scr, r, lane); continue; } r -= I_IN;
        if (r < I_HO) { transpose_item(IN(23), HYW, DM_, (bf16*)(ws + WS_HYO), BIGN, 0, 0, nullptr, scr, r, lane); continue; } r -= I_HO;
        if (r < I_HO) { transpose_item(IN(24), HYW, DM_, (bf16*)(ws + WS_ATO), BIGN, 0, 0, nullptr, scr, r, lane); continue; } r -= I_HO;
        if (r < I_O) { transpose_item(IN(25), DM_, DM_, (bf16*)(ws + WS_OUT), BIGN, 0, 0, nullptr, scr, r, lane); continue; } r -= I_O;
        if (r < I_G) { transpose_item(IN(28), DM_, FF, (bf16*)(ws + WS_GU2), 128, 256, 0, IN(26), scr, r, lane); continue; } r -= I_G;
        if (r < I_G) { transpose_item(IN(29), DM_, FF, (bf16*)(ws + WS_GU2), 128, 256, 128, IN(26), scr, r, lane); continue; } r -= I_G;
        if (r < I_D) { transpose_item(IN(30), FF, DM_, (bf16*)(ws + WS_D2), BIGN, 0, 0, nullptr, scr, r, lane); continue; } r -= I_D;
        if (r < I_O) { transpose_item(IN(33), DM_, DM_, (bf16*)(ws + WS_PG), BIGN, 0, 0, IN(31), scr, r, lane); continue; } r -= I_O;
        transpose_item(IN(34), PLE, DM_, (bf16*)(ws + WS_PP), BIGN, 0, 0, nullptr, scr, r, lane);
    }
    { const float* x = IN(0); bf16* xb = (bf16*)(ws + WS_XB); float* rs = (float*)(ws + WS_RS);
      for (int row0 = gw; row0 < M; row0 += 2 * NGW) { f32x4 v[2][4];
#pragma unroll
          for (int u = 0; u < 2; ++u) { const int row = (row0 + u * NGW < M) ? row0 + u * NGW : row0; const f32x4* xr = (const f32x4*)(x + (size_t)row * DM_) + lane;
#pragma unroll
              for (int j = 0; j < 4; ++j) v[u][j] = xr[64 * j]; }
#pragma unroll
          for (int u = 0; u < 2; ++u) { const int row = row0 + u * NGW;
              if (row < M) { v2u* o8 = (v2u*)(xb + (size_t)row * DM_) + lane; float ss = 0.f;
#pragma unroll
                  for (int j = 0; j < 4; ++j) { v2u o; o.x = pk2(v[u][j][0], v[u][j][1]); o.y = pk2(v[u][j][2], v[u][j][3]); o8[64 * j] = o;
                      f32x4 xq; xq[0] = bflo(o.x); xq[1] = bfhi(o.x); xq[2] = bflo(o.y); xq[3] = bfhi(o.y); ss += sq4v(xq); }
                  ss = wave_sum(ss); if (lane == 0) rs[row] = 1.0f / sqrtf(ss * (1.0f / DM_) + EPS); } } } }
    { const float *w1 = IN(12), *b1 = IN(13), *f1 = IN(14), *w2 = IN(15), *b2 = IN(16), *f2 = IN(17); float* h2 = (float*)(ws + WS_H2);
      for (int t = gw; t < SEQ; t += NGW) {
          const float tl = (float)t * (1.0f / (float)(SEQ - 1)); const float wv = (float)(2.0 * 3.14159265358979323846 / SEQ) * (float)t;
          float z = 0.f;
          if (lane == 0) z = tl; else if (lane <= 32) { const int bi = (lane - 1) & 15; const float band = 1e-4f + (float)bi * ((15.0f - 1e-4f) / 15.0f); const float ang = wv * band; z = (lane <= 16) ? cosf(ang) : -sinf(ang); }
          float acc = b1[lane];
          for (int i = 0; i < 33; ++i) acc += __shfl(z, i) * w1[i * 64 + lane];
          const float h1 = sinf(f1[lane] * acc);
          float acc2 = b2[lane];
          for (int i = 0; i < 64; ++i) acc2 += __shfl(h1, i) * w2[i * 64 + lane];
          h2[t * 64 + lane] = sinf(f2[lane] * acc2); } }
    { f32x2* rope = (f32x2*)(ws + WS_ROPE);
      for (int idx = (F.vcu * NTHR + F.tid); idx < SEQ * 32; idx += F.G * NTHR) { const int t = idx >> 5, i = idx & 31; const float pos = (i < 16) ? (float)(t >> 6) : (float)(t & 63);
          const float inv = powf(10000.0f, -(float)(2 * (i & 15)) / 32.0f); const float ang = pos * inv; rope[idx] = (f32x2){cosf(ang), sinf(ang)}; } }
}

__device__ __forceinline__ void filter_cols(const Frame& F) {
    unsigned char* ws_ = karg_ws();
    const float* h2 = (const float*)(ws_ + WS_H2); const float* w3 = IN(18); const float* dl = IN(19); bf16* filt = (bf16*)(ws_ + WS_FILT);
    LAS float* sw = (LAS float*)F.lds; LAS float* red = sw + 128;
    for (int pr = blockIdx.x; pr < 2 * HYW; pr += F.G) {
        const int o = pr / HYW, c = pr % HYW, colf = o * 2 * HYW + c, colb = colf + HYW;
        if (F.tid < 128) sw[F.tid] = w3[(size_t)(F.tid & 63) * (4 * HYW) + (F.tid < 64 ? colf : colb)];
        __syncthreads();
        const float df = fabsf(dl[colf]), db = fabsf(dl[colb]);
        float hf[8], hb[8]; float s = 0.f;
#pragma unroll
        for (int i = 0; i < 8; ++i) { const int t = F.tid + NTHR * i; const f32x4* row = (const f32x4*)(h2 + (size_t)t * 64); float af = 0.f, ab = 0.f;
#pragma unroll
            for (int j = 0; j < 16; ++j) { const f32x4 v = row[j]; af += v[0] * sw[4 * j] + v[1] * sw[4 * j + 1] + v[2] * sw[4 * j + 2] + v[3] * sw[4 * j + 3];
                ab += v[0] * sw[64 + 4 * j] + v[1] * sw[64 + 4 * j + 1] + v[2] * sw[64 + 4 * j + 2] + v[3] * sw[64 + 4 * j + 3]; }
            const float tl = (float)t * (1.0f / (float)(SEQ - 1)); hf[i] = af * expf(-tl * df); hb[i] = ab * expf(-tl * db);
            s += (t == 0) ? fabsf(hf[i] + hb[i]) : (fabsf(hf[i]) + fabsf(hb[i]));  asm volatile("" ::: "memory"); }
        s = wave_sum(s); if (F.lane == 0) red[F.wave] = s;
        __syncthreads();
        float tot = 0.f;
#pragma unroll
        for (int w = 0; w < NWAVES; ++w) tot += red[w];
        const float inv = 1.0f / tot; bf16* Fp = filt + (size_t)pr * 8192;
#pragma unroll
        for (int i = 0; i < 8; ++i) { const int t = F.tid + NTHR * i;
            if (t == 0) { Fp[4095] = (bf16)f2bf((hf[i] + hb[i]) * inv); Fp[8191] = 0; }
            else { Fp[4095 - t] = (bf16)f2bf(hf[i] * inv); Fp[4095 + t] = (bf16)f2bf(hb[i] * inv); } }
        __syncthreads();
    }
}

__device__ __forceinline__ void elem_pass(const Frame& F, bf16* xb, const bf16* hb, const float* part, const float* gpost, float scale, float* xout, float* rsout, bool last) {
    const int gw = F.vcu * NWAVES + F.wave, NGW = F.G * NWAVES, lane = F.lane;
    f32x4 g[4];
#pragma unroll
    for (int j = 0; j < 4; ++j) g[j] = ((const f32x4*)gpost)[lane + 64 * j];
    for (int row0 = gw; row0 < M; row0 += 2 * NGW) {
        v2u xw[2][4], hw[2][4]; float pv[2];
#pragma unroll
        for (int u = 0; u < 2; ++u) { const int row = (row0 + u * NGW < M) ? row0 + u * NGW : row0;
            pv[u] = (lane < 16) ? part[(size_t)row * 16 + lane] : 0.f;
            const v2u* xr = (const v2u*)(xb + (size_t)row * DM_) + lane; const v2u* hr = (const v2u*)(hb + (size_t)row * DM_) + lane;
#pragma unroll
            for (int j = 0; j < 4; ++j) { xw[u][j] = xr[64 * j]; hw[u][j] = __builtin_nontemporal_load(hr + 64 * j); } }
#pragma unroll
        for (int u = 0; u < 2; ++u) { const int row = row0 + u * NGW;
            if (row < M) {
                const float rh = scale / sqrtf(wave_sum(pv[u]) * (1.0f / DM_) + EPS);
                v2u* xr = (v2u*)(xb + (size_t)row * DM_) + lane; f32x4* xo = (f32x4*)(xout + (size_t)row * DM_) + lane; float ss = 0.f;
#pragma unroll
                for (int j = 0; j < 4; ++j) { const v2u xv = xw[u][j], h = hw[u][j]; f32x4 x, hv;
                    x[0] = bflo(xv.x); x[1] = bfhi(xv.x); x[2] = bflo(xv.y); x[3] = bfhi(xv.y); hv[0] = bflo(h.x); hv[1] = bfhi(h.x); hv[2] = bflo(h.y); hv[3] = bfhi(h.y);
                    const f32x4 xn = x + hv * g[j] * rh;
                    if (last) __builtin_nontemporal_store(xn, xo + 64 * j);
                    else { v2u o; o.x = pk2(xn[0], xn[1]); o.y = pk2(xn[2], xn[3]); xr[64 * j] = o;
                           f32x4 xq; xq[0] = bflo(o.x); xq[1] = bfhi(o.x); xq[2] = bflo(o.y); xq[3] = bfhi(o.y); ss += sq4v(xq); } }
                if (!last) { ss = wave_sum(ss); if (lane == 0) rsout[row] = 1.0f / sqrtf(ss * (1.0f / DM_) + EPS); }
            } }
    }
}

__device__ __forceinline__ void qk_prep(const Frame& F) {
    unsigned char* ws_ = karg_ws();
    bf16* q = (bf16*)(ws_ + WS_Q); bf16* k = (bf16*)(ws_ + WS_K); const f32x2* rope = (const f32x2*)(ws_ + WS_ROPE); const float *qn = IN(21), *kn = IN(22);
    const int gt = F.vcu * NTHR + F.tid, sub = gt & 7; const int ngrp = F.G * NTHR / 8;
    for (int g0 = gt >> 3; g0 < M * 10; g0 += 4 * ngrp) {
        v4u wv[4];
#pragma unroll
        for (int u = 0; u < 4; ++u) { const int g = (g0 + u * ngrp < M * 10) ? g0 + u * ngrp : g0; const int tok = g / 10, hh = g - tok * 10;
            const bf16* p = (hh < 8 ? q + (size_t)tok * 512 + hh * 64 : k + (size_t)tok * 128 + (hh - 8) * 64) + sub * 8; wv[u] = *(const v4u*)p; }
#pragma unroll
        for (int u = 0; u < 4; ++u) { const int g = g0 + u * ngrp;
            if (g < M * 10) {
                const int tok = g / 10, hh = g - tok * 10; bf16* p = (hh < 8 ? q + (size_t)tok * 512 + hh * 64 : k + (size_t)tok * 128 + (hh - 8) * 64) + sub * 8;
                const v4u w = wv[u]; float x[8] = {bflo(w.x), bfhi(w.x), bflo(w.y), bfhi(w.y), bflo(w.z), bfhi(w.z), bflo(w.w), bfhi(w.w)};
                float ss = 0.f;
#pragma unroll
                for (int e = 0; e < 8; ++e) ss += x[e] * x[e];
                ss += __shfl_xor(ss, 1); ss += __shfl_xor(ss, 2); ss += __shfl_xor(ss, 4);
                const float r = 1.0f / sqrtf(ss * (1.0f / 64.0f) + EPS); const float* gn = (hh < 8 ? qn : kn) + sub * 8; const float sc = (hh < 8) ? QSCALE : 1.0f;
                const f32x2* rp = rope + (size_t)(tok & (SEQ - 1)) * 32 + sub * 4; float y[8];
#pragma unroll
                for (int e = 0; e < 4; ++e) { const float y0 = x[2 * e] * r * gn[2 * e], y1 = x[2 * e + 1] * r * gn[2 * e + 1]; const f32x2 cs = rp[e];
                    y[2 * e] = (y0 * cs.x - y1 * cs.y) * sc; y[2 * e + 1] = (y0 * cs.y + y1 * cs.x) * sc; }
                v4u o; o.x = pk2(y[0], y[1]); o.y = pk2(y[2], y[3]); o.z = pk2(y[4], y[5]); o.w = pk2(y[6], y[7]); *(v4u*)p = o;
            } }
    }
}

__device__ __forceinline__ void hyena_phase(const Frame& F) {
    unsigned char* ws_ = karg_ws();
    const bf16* hyT = (const bf16*)(ws_ + WS_HYT); const bf16* filt = (const bf16*)(ws_ + WS_FILT); bf16* yaT = (bf16*)(ws_ + WS_HB);
    const float *sw = IN(10), *sb = IN(11), *hbias = IN(20);
    LAS bf16* Z = (LAS bf16*)F.lds + ZO; LAS bf16* FL = (LAS bf16*)(F.lds + HY_F_OFF);
    const int tid = F.tid, lane = F.lane, w = F.wave, fr = lane & 15, fq = lane >> 4;
    for (int e = F.tid; e < 16 * 48; e += NTHR) { const int b = e / 48, j = e % 48; const int col = j < 24 ? -192 + 8 * j : 4096 + 8 * (j - 24); *(LAS v4u*)(Z + b * ZS + col) = (v4u){0u, 0u, 0u, 0u}; }
    __syncthreads();
    for (int c = F.vcu; c < HYW; c += F.G) {
        { const bf16* src = hyT + (size_t)c * M; const float w0 = sw[c], w1 = sw[3 * HYW + c], w2 = sw[6 * HYW + c], bb = sb[c];
          int tz = tid; asm volatile("" : "+v"(tz));
#pragma unroll 4
          for (int i = 0; i < 16; ++i) { const int qd = tz + NTHR * i, b = qd >> 9, t0 = (qd & 511) * 8; const bf16* p = src + b * SEQ + t0; const v4u v = *(const v4u*)p;
              float x[10]; { const float xm = bf1(p[-1]), xp = bf1(p[8]); x[0] = t0 > 0 ? xm : 0.f; x[9] = (t0 + 8 < SEQ) ? xp : 0.f; }
              x[1] = bflo(v.x); x[2] = bfhi(v.x); x[3] = bflo(v.y); x[4] = bfhi(v.y); x[5] = bflo(v.z); x[6] = bfhi(v.z); x[7] = bflo(v.w); x[8] = bfhi(v.w);
              float y[8];
#pragma unroll
              for (int e = 0; e < 8; ++e) y[e] = w0 * x[e] + w1 * x[e + 1] + w2 * x[e + 2] + bb;
              v4u o; o.x = pk2(y[0], y[1]); o.y = pk2(y[2], y[3]); o.z = pk2(y[4], y[5]); o.w = pk2(y[6], y[7]); *(LAS v4u*)(Z + b * ZS + t0) = o; } }
        for (int o = 0; o < 2; ++o) {
            { int tf = tid; asm volatile("" : "+v"(tf)); const v4u* fs = (const v4u*)(filt + (size_t)(o * HYW + c) * 8192); ((LAS v4u*)FL)[tf] = fs[tf]; ((LAS v4u*)FL)[tf + NTHR] = fs[tf + NTHR]; }
            __syncthreads();
            f32x4 acc[8][4];
#pragma unroll
            for (int i = 0; i < 8; ++i)
#pragma unroll
                for (int mt = 0; mt < 4; ++mt) acc[i][mt] = (f32x4){0.f, 0.f, 0.f, 0.f};
            const LAS unsigned* FLd = (const LAS unsigned*)FL; const int qbase = 4127 - fr + 8 * fq; const unsigned fsh = (qbase & 1) ? 16u : 0u;
            const LAS bf16* zrow = Z + fr * ZS + 8 * fq;
            bf16x8 af[6];
#define HYC_PIN2(a, b) asm volatile("" : "+v"(wr[a][0]), "+v"(wr[a][1]), "+v"(wr[a][2]), "+v"(wr[a][3]), "+v"(wr[a][4]), "+v"(wr[b][0]), "+v"(wr[b][1]), "+v"(wr[b][2]), "+v"(wr[b][3]), "+v"(wr[b][4]))
#define HYC_FRAG(dd) do { unsigned wr[6][5]; \
                _Pragma("unroll") for (int k = 0; k < 6; ++k) { const LAS unsigned* wp = FLd + ((qbase - 64 * (dd) - 16 * k) >> 1); \
                    _Pragma("unroll") for (int i5 = 0; i5 < 5; ++i5) wr[k][i5] = wp[i5]; } \
                HYC_PIN2(0, 1); HYC_PIN2(2, 3); HYC_PIN2(4, 5); \
                _Pragma("unroll") for (int k = 0; k < 6; ++k) { v4u fv; fv.x = __builtin_amdgcn_alignbit(wr[k][1], wr[k][0], fsh); fv.y = __builtin_amdgcn_alignbit(wr[k][2], wr[k][1], fsh); \
                    fv.z = __builtin_amdgcn_alignbit(wr[k][3], wr[k][2], fsh); fv.w = __builtin_amdgcn_alignbit(wr[k][4], wr[k][3], fsh); af[k] = __builtin_bit_cast(bf16x8, fv); } } while (0)
#define HYC_TB(j) (8 * w + (j))
#define HYC_ZLD2(buf, jp, dpv) do { _Pragma("unroll") for (int t2 = 0; t2 < 2; ++t2) { const int sb_ = (HYC_TB(2 * (jp) + t2) - (dpv)) & 63; const volatile LAS v4u* zp_ = (const volatile LAS v4u*)(zrow + 64 * sb_); \
                    zP[buf][t2][0] = zp_[0]; zP[buf][t2][1] = zp_[4]; } } while (0)
            v4u zP[2][2][2];
            HYC_ZLD2(0, 0, 0);
            for (int dp = 0; dp < 64; ++dp) {
                const int n_ = dp - 8 * w; const int nN = n_ < 0 ? 0 : (n_ > 8 ? 8 : n_);
                { const int d0 = nN > 0 ? dp - 64 : dp; HYC_FRAG(d0); }
#pragma unroll
                for (int jp = 0; jp < 4; ++jp) {
                    if (jp < 3) HYC_ZLD2((jp + 1) & 1, jp + 1, dp); else HYC_ZLD2(0, 0, dp + 1);
#pragma unroll
                    for (int t2 = 0; t2 < 2; ++t2) { const int j = 2 * jp + t2;
                        if (j > 0 && j == nN) HYC_FRAG(dp);
                        const bf16x8 z0 = __builtin_bit_cast(bf16x8, zP[jp & 1][t2][0]), z1 = __builtin_bit_cast(bf16x8, zP[jp & 1][t2][1]);
#pragma unroll
                        for (int mt = 0; mt < 4; ++mt) acc[j][mt] = __builtin_amdgcn_mfma_f32_16x16x32_bf16(af[mt + 2], z0, acc[j][mt], 0, 0, 0);
#pragma unroll
                        for (int mt = 0; mt < 4; ++mt) acc[j][mt] = __builtin_amdgcn_mfma_f32_16x16x32_bf16(af[mt], z1, acc[j][mt], 0, 0, 0); }
                }
            }
#undef HYC_PIN2
#undef HYC_FRAG
#undef HYC_TB
#undef HYC_ZLD2
            int el_ = tid; asm volatile("" : "+v"(el_)); const int efr = el_ & 15, efq = (el_ >> 4) & 3;
            const int gch = (o + 1) * HYW + c; const bf16* gsrc = hyT + (size_t)gch * M + efr * SEQ; const float w0 = sw[gch], w1 = sw[3 * HYW + gch], w2 = sw[6 * HYW + gch], bb = sb[gch], hbv = hbias[o * HYW + c];
#pragma unroll
            for (int i = 0; i < 8; ++i) { int t0i = 64 * (8 * w + i) + 4 * efq; asm volatile("" : "+v"(t0i));
#pragma unroll
                for (int mt = 0; mt < 4; ++mt) { const int t0 = t0i + 16 * mt; const bf16* p = gsrc + t0; const v2u gv = *(const v2u*)p;
                    float x[6]; { const float xm = bf1(p[-1]), xp = bf1(p[4]); x[0] = (t0 & (SEQ - 1)) != 0 ? xm : 0.f; x[5] = ((t0 + 4) & (SEQ - 1)) != 0 ? xp : 0.f; } x[1] = bflo(gv.x); x[2] = bfhi(gv.x); x[3] = bflo(gv.y); x[4] = bfhi(gv.y);
                    const v2u zv = *(const LAS v2u*)(Z + efr * ZS + t0); const float zz[4] = {bflo(zv.x), bfhi(zv.x), bflo(zv.y), bfhi(zv.y)};
#pragma unroll
                    for (int j = 0; j < 4; ++j) { const float gte = w0 * x[j] + w1 * x[j + 1] + w2 * x[j + 2] + bb; acc[i][mt][j] = gte * (acc[i][mt][j] + zz[j] * hbv); }
                    asm volatile("" ::: "memory"); } }
            __syncthreads();
            if (o == 0) {
#pragma unroll
                for (int i = 0; i < 8; ++i) { int t0i = 64 * (8 * w + i) + 4 * efq; asm volatile("" : "+v"(t0i));
#pragma unroll
                    for (int mt = 0; mt < 4; ++mt) { const int t0 = t0i + 16 * mt; v2u ov; ov.x = pk2(acc[i][mt][0], acc[i][mt][1]); ov.y = pk2(acc[i][mt][2], acc[i][mt][3]); *(LAS v2u*)(Z + efr * ZS + t0) = ov; } }
            } else {
#pragma unroll
                for (int i = 0; i < 8; ++i) { int t0i = 64 * (8 * w + i) + 4 * efq; asm volatile("" : "+v"(t0i));
#pragma unroll
                    for (int mt = 0; mt < 4; ++mt) { const int t0 = t0i + 16 * mt; v2u ov; ov.x = pk2(acc[i][mt][0], acc[i][mt][1]); ov.y = pk2(acc[i][mt][2], acc[i][mt][3]);
                        *(v2u*)(yaT + (size_t)c * M + (size_t)efr * SEQ + t0) = ov; }
                    asm volatile("" ::: "memory"); }
            }
        }
        __syncthreads();
    }
}
__device__ __forceinline__ void ya_transpose(const Frame& F) {
    unsigned char* ws_ = karg_ws(); const bf16* yT = (const bf16*)(ws_ + WS_HB); bf16* ya = (bf16*)(ws_ + WS_YA);
    LAS bf16* sT = (LAS bf16*)F.lds;
    const int ch = F.tid & 7, r = F.tid >> 3;
    v4u v[4];
    { const int gi = F.vcu < 8 * 256 ? F.vcu : 0; const int c0 = 64 * (gi & 7), t0 = 256 * (gi >> 3);
#pragma unroll
      for (int k = 0; k < 4; ++k) v[k] = *(const v4u*)(yT + (size_t)(c0 + r) * M + t0 + 64 * k + 8 * ch); }
    for (int gi = F.vcu; gi < 8 * 256; gi += F.G) {
        const int c0 = 64 * (gi & 7), t0 = 256 * (gi >> 3);
        v4u vn[4];
        { const int gn = gi + F.G < 8 * 256 ? gi + F.G : gi; const int cn = 64 * (gn & 7), tn = 256 * (gn >> 3);
#pragma unroll
          for (int k = 0; k < 4; ++k) vn[k] = *(const v4u*)(yT + (size_t)(cn + r) * M + tn + 64 * k + 8 * ch); }
#pragma unroll
        for (int k = 0; k < 4; ++k) { LAS bf16* d = sT + k * (64 * 66) + (8 * ch) * 66 + r; const unsigned w[4] = {v[k].x, v[k].y, v[k].z, v[k].w};
#pragma unroll
            for (int j = 0; j < 4; ++j) { d[(2 * j) * 66] = (bf16)(w[j] & 0xffffu); d[(2 * j + 1) * 66] = (bf16)(w[j] >> 16); } }
        __syncthreads();
#pragma unroll
        for (int k = 0; k < 4; ++k) { const LAS unsigned* sp = (const LAS unsigned*)(sT + k * (64 * 66) + r * 66 + 8 * ch); v4u o; o.x = sp[0]; o.y = sp[1]; o.z = sp[2]; o.w = sp[3];
            *(v4u*)(ya + (size_t)(t0 + 64 * k + r) * HYW + c0 + 8 * ch) = o; }
        __syncthreads();
#pragma unroll
        for (int k = 0; k < 4; ++k) v[k] = vn[k];
    }
}

constexpr int N_STEPS = 15;
#ifndef ONE_LAUNCH
#define ONE_LAUNCH 1
#endif
#ifndef STEP_MASK
#define STEP_MASK 0xFFFF
#endif
__device__ __forceinline__ bool gemm_desc(int st, int q, unsigned char* ws, pg8::Gemm& g, pg8::EpiGen& e) {
    bf16* XB = (bf16*)(ws + WS_XB); bf16* HB = (bf16*)(ws + WS_HB);
    e.ws = ws; e.aux = nullptr; e.O = HB; e.ldc = DM_; e.midk = 0;
    if (q == 0) {
        switch (st) {
        case 1: case 10: g = pg8::Gemm{XB, (const bf16*)(ws + (st == 10 ? WS_GU2 : WS_GU1)), M, 2 * FF, DM_}; e.mode = pg8::EM_SWIGLU; e.O = (bf16*)(ws + WS_ACT); e.ldc = FF; return true;
        case 2: case 11: g = pg8::Gemm{(const bf16*)(ws + WS_ACT), (const bf16*)(ws + (st == 11 ? WS_D2 : WS_D1)), M, DM_, FF}; e.mode = pg8::EM_HSUM; return true;
        case 4: g = pg8::Gemm{(const bf16*)(ws + WS_IN), XB, 3 * HYW, M, DM_}; e.mode = pg8::EM_HYT; e.O = (bf16*)(ws + WS_HYT); e.ldc = M; return true;
        case 7: g = pg8::Gemm{(const bf16*)(ws + WS_YA), (const bf16*)(ws + WS_HYO), M, DM_, HYW, (const bf16*)(ws + WS_YB), (const bf16*)(ws + WS_ATO)}; e.mode = pg8::EM_MERGEA; e.O = (bf16*)(ws + WS_MRG); e.aux = (const bf16*)(ws + WS_SGB); e.midk = 1; return true;
        case 8: g = pg8::Gemm{(const bf16*)(ws + WS_MRG), (const bf16*)(ws + WS_OUT), M, DM_, DM_}; e.mode = pg8::EM_HSUM; return true;
        case 13: g = pg8::Gemm{(const bf16*)(ws + WS_PB), (const bf16*)(ws + WS_PP), M, DM_, PLE}; e.mode = pg8::EM_PLAIN; e.O = (bf16*)(ws + WS_PBUF); return true;
        default: return false;
        }
    } else {
        switch (st) {
        case 4: g = pg8::Gemm{XB, (const bf16*)(ws + WS_IN) + (size_t)3 * HYW * DM_, M, INC - 3 * HYW, DM_}; e.mode = pg8::EM_QKVG; return true;
        case 13: g = pg8::Gemm{XB, (const bf16*)(ws + WS_PG), M, DM_, DM_}; e.mode = pg8::EM_PLEG; e.aux = (const bf16*)(ws + WS_PBUF); return true;
        default: return false;
        }
    }
}
__global__ void __launch_bounds__(NTHR, 2) fwd_kernel(Args args) {
    extern __shared__ __attribute__((aligned(16))) unsigned char lds[];
    const int step_lo = args.step_lo, step_hi = args.step_hi;
    if (threadIdx.x < 2) ((volatile LAS unsigned*)((LAS unsigned char*)lds + BARST_OFF))[threadIdx.x] = 0u;
    __syncthreads();
    const XcdBarrier bar = xcd_barrier_post((unsigned*)karg_ws(), (volatile LAS unsigned*)((LAS unsigned char*)lds + BARST_OFF));
    for (int st = step_lo; st < step_hi; ++st) {
        if (st > step_lo) { if (st == step_lo + 1) cg::this_grid().sync(); else xcd_barrier(bar); }
        if (!((STEP_MASK >> st) & 1)) continue;
        unsigned char* ws = karg_ws();
        int tid_ = threadIdx.x; asm volatile("" : "+v"(tid_));
        Frame F; F.lds = (LAS unsigned char*)lds; F.tid = tid_; F.lane = F.tid & 63; F.wave = __builtin_amdgcn_readfirstlane(F.tid >> 6);
        F.G = gridDim.x; { const int bx = blockIdx.x; F.vcu = (F.G % 8 == 0) ? (bx % 8) * (F.G / 8) + bx / 8 : bx; }
        bf16* XB = (bf16*)(ws + WS_XB); bf16* HB = (bf16*)(ws + WS_HB); float* RS = (float*)(ws + WS_RS); float* PART = (float*)(ws + WS_PART);
        switch (st) {
        case 0: if constexpr (STEP_MASK & 1) prologue(F); break;
        case 1: if constexpr ((STEP_MASK >> 1) & 1) filter_cols(F); break;
        case 5: if constexpr ((STEP_MASK >> 5) & 1) { qk_prep(F); hyena_phase(F); } break;
        case 6: if constexpr ((STEP_MASK >> 6) & 1) { ya_transpose(F); const attn_body::AttnTensors AT{(const attn_body::bf16*)(ws + WS_Q), (const attn_body::bf16*)(ws + WS_K), (const attn_body::bf16*)(ws + WS_V), (attn_body::bf16*)(ws + WS_YB)};
            const attn_body::StaticOrder S((int)F.G, (int)blockIdx.x); attn_body::attn_phase<attn_body::StaticOrder>((char*)lds, AT, S); } break;
        case 12: if constexpr ((STEP_MASK >> 12) & 1) {
            { const f32x4* p4 = (const f32x4*)IN(1); v2u* pb = (v2u*)(ws + WS_PB);
              for (int i = F.vcu * NTHR + F.tid; i < M * PLE / 4; i += F.G * NTHR) { const f32x4 v = p4[i]; v2u o; o.x = pk2(v[0], v[1]); o.y = pk2(v[2], v[3]); pb[i] = o; } } } break;
        default: break;
        }
        if (st == 3 || st == 9 || st == 12 || st == 14) {
            const float* gp = IN(st == 3 ? 3 : st == 9 ? 8 : st == 12 ? 27 : 32);
            elem_pass(F, XB, HB, PART, gp, (st == 3 || st == 12) ? 0.5f : 1.0f, karg_out(), RS, st == 14);
        }
#ifndef NO_GEMM
        for (int q = 0; q < 2; ++q) {
            pg8::Gemm g; pg8::EpiGen e;
            if (!gemm_desc(st, q, ws, g, e)) break;
            pg8::StaticOrder S; S.init(g.M, g.N, F.G, (int)blockIdx.x); S.dual = e.midk;
            pg8::gemm_phase<pg8::EpiGen, pg8::StaticOrder, true, true>(F.lds, g, S, e);
            __syncthreads();
        }
#endif
    }
}

extern "C" void kernel_launch(void* const* d_in, const int* in_sizes, int n_in, void* d_out, int out_size, void* d_ws, size_t ws_size, hipStream_t stream) {
    static int grid = 0;
    if (grid == 0) {
        if (n_in != 35 || ws_size < WS_END) { fprintf(stderr, "kernel_launch: unexpected n_in %d / ws %zu\n", n_in, ws_size); grid = -1; return; }
        int dev = 0, cus = 0, per_cu = 0;
        (void)hipGetDevice(&dev); (void)hipDeviceGetAttribute(&cus, hipDeviceAttributeMultiprocessorCount, dev);
        if (hipFuncSetAttribute((const void*)fwd_kernel, hipFuncAttributeMaxDynamicSharedMemorySize, LDS_BYTES) != hipSuccess) { fprintf(stderr, "kernel_launch: hipFuncSetAttribute failed\n"); grid = -1; return; }
        if (hipOccupancyMaxActiveBlocksPerMultiprocessor(&per_cu, (const void*)fwd_kernel, NTHR, LDS_BYTES) != hipSuccess || per_cu < 1) { fprintf(stderr, "kernel_launch: occupancy query says %d\n", per_cu); per_cu = 1; }
        (void)hipGetLastError();
        grid = cus > 0 ? cus : 256;
    }
    if (grid < 0) return;
    if (hipMemsetAsync(d_ws, 0, CTL_ZERO_BYTES, stream) != hipSuccess) { fprintf(stderr, "kernel_launch: memset of the barrier words failed\n"); return; }
    Args a{};
    for (int i = 0; i < 35; ++i) a.in[i] = (const float*)d_in[i];
    a.out = (float*)d_out; a.ws = (unsigned char*)d_ws;
#if ONE_LAUNCH
    a.step_lo = 0; a.step_hi = N_STEPS;
    void* kargs[] = {&a};
    hipError_t e = hipLaunchCooperativeKernel((const void*)fwd_kernel, dim3(grid), dim3(NTHR), kargs, LDS_BYTES, stream);
    if (e != hipSuccess) fprintf(stderr, "cooperative launch failed: %s (grid %d)\n", hipGetErrorString(e), grid);
#else
    for (int st = 0; st < N_STEPS; ++st) { a.step_lo = st; a.step_hi = st + 1; hipLaunchKernelGGL(fwd_kernel, dim3(grid), dim3(NTHR), LDS_BYTES, stream, a); }
#endif
}
```

```cpp
#include <hip/hip_runtime.h>
#include <hip/hip_cooperative_groups.h>
#include <hip/hip_bf16.h>
#include <cstdio>
#include <cstdint>
#include <cmath>
namespace cg = cooperative_groups;
constexpr int DM_ = 1024, BATCH = 16, SEQ = 4096, M = BATCH * SEQ, FF = 2816, HYW = 512, PLE = 256, INC = 4352;
constexpr float EPS = 1e-6f;
constexpr float QSCALE = 0.125f * 1.4426950408889634f;
constexpr size_t MiB = 1u << 20;
constexpr size_t WS_GU1 = 1 * MiB, WS_D1 = 12 * MiB, WS_IN = 18 * MiB, WS_HYO = 27 * MiB, WS_ATO = 28 * MiB, WS_OUT = 29 * MiB, WS_GU2 = 31 * MiB, WS_D2 = 42 * MiB, WS_PG = 48 * MiB, WS_PP = 50 * MiB;
constexpr size_t WS_FILT = 52 * MiB, WS_H2 = 68 * MiB, WS_ROPE = 69 * MiB, WS_RS = 70 * MiB, WS_PART = 71 * MiB;
constexpr size_t WS_XB = 76 * MiB, WS_HB = 204 * MiB, WS_BIG = 332 * MiB;
constexpr size_t WS_ACT = WS_BIG, WS_HYT = WS_BIG, WS_SGA = 524 * MiB, WS_SGB = 652 * MiB, WS_Q = 780 * MiB, WS_K = 844 * MiB, WS_V = 860 * MiB, WS_YA = 876 * MiB, WS_MRG = WS_BIG;
constexpr size_t WS_PB = WS_BIG, WS_PBUF = 364 * MiB, WS_YB = 940 * MiB, WS_END = 1004 * MiB;
namespace pg8 {
#define PG8_LAS __attribute__((address_space(3)))
typedef unsigned short bf16_t;
typedef short bf16x8 __attribute__((ext_vector_type(8)));
typedef float f32x4 __attribute__((ext_vector_type(4)));
typedef unsigned u32x4 __attribute__((ext_vector_type(4)));
constexpr int BM = 256, BK = 64, HALF = 128, HTB = HALF * BK * 2  , STAGE_BYTES = 8 * HTB, NXCD = 8, WGM = 4;

__host__ __device__ __forceinline__ int lds_byte(int r, int c) { const int st = (r >> 4) * 2 + (c >> 5), rr = r & 15, cc = c & 31, ob = rr * 64 + cc * 2; return st * 1024 + (ob ^ (((ob >> 9) & 1) << 5)); }
__host__ __device__ __forceinline__ void stage_rc(int b, int& R, int& C) { const int st = b / 1024, sb = b % 1024, swz = sb ^ (((sb >> 9) & 1) << 5); R = (st >> 1) * 16 + swz / 64; C = (st & 1) * 32 + (swz % 64) / 2; }
__host__ __device__ __forceinline__ int perm32(int rho) { const int n = rho >> 4, i = rho & 15; return 8 * (i >> 2) + 4 * n + (i & 3); }

struct Unit { int pm, pn, half; };
struct Gemm { const bf16_t* A; const bf16_t* Bt; int M, N, K; const bf16_t* A2; const bf16_t* Bt2; };

struct StaticOrder {
    int nM, nN, nwg, G, c, dual;
    __host__ __device__ void init(int M, int N, int G_, int c_) { nM = M / BM; nN = N / BM; nwg = nM * nN; G = G_; c = c_; dual = 0; }
    __host__ __device__ bool next(int i, Unit& u) const {
        const int ii = dual ? (i >> 1) : i; u.half = dual ? (i & 1) : 0;
        const long L = (long)ii * G + c; if (L >= nwg) return false;
        int wgid = (int)L; { const int q = nwg / NXCD, r = nwg % NXCD, xcd = wgid % NXCD, off = wgid / NXCD; wgid = (xcd < r ? xcd * (q + 1) : r * (q + 1) + (xcd - r) * q) + off; }
        const int nig = WGM * nN, gid = wgid / nig, fm = gid * WGM, gsz = (nM - fm) < WGM ? (nM - fm) : WGM;
        u.pm = fm + ((wgid % nig) % gsz); u.pn = (wgid % nig) / gsz; return true;
    }
    __device__ __forceinline__ void a_ready(const Unit&) const {}
    __device__ __forceinline__ void done(const Unit&) const {}
};

__device__ __forceinline__ unsigned cvt_pk_bf16(float lo, float hi) { unsigned r; asm volatile("v_cvt_pk_bf16_f32 %0, %1, %2" : "=v"(r) : "v"(lo), "v"(hi)); return r; }
typedef float f32x2 __attribute__((ext_vector_type(2)));
enum { EM_SWIGLU = 0, EM_HSUM = 1, EM_HYT = 2, EM_QKVG = 3, EM_MERGEA = 4, EM_MERGEB = 5, EM_PLAIN = 6, EM_PLEG = 7 };
__device__ __forceinline__ void st8(bf16_t* p, f32x4 v0, f32x4 v1) { u32x4 w; w.x = cvt_pk_bf16(v0[0], v0[1]); w.y = cvt_pk_bf16(v0[2], v0[3]); w.z = cvt_pk_bf16(v1[0], v1[1]); w.w = cvt_pk_bf16(v1[2], v1[3]); *(u32x4*)p = w; }
__device__ __forceinline__ void ld8(const bf16_t* p, f32x4& v0, f32x4& v1) { const u32x4 w = *(const u32x4*)p;
    v0[0] = __uint_as_float(w.x << 16); v0[1] = __uint_as_float(w.x & 0xffff0000u); v0[2] = __uint_as_float(w.y << 16); v0[3] = __uint_as_float(w.y & 0xffff0000u);
    v1[0] = __uint_as_float(w.z << 16); v1[1] = __uint_as_float(w.z & 0xffff0000u); v1[2] = __uint_as_float(w.w << 16); v1[3] = __uint_as_float(w.w & 0xffff0000u); }
__device__ __forceinline__ void un8(const u32x4 w, f32x4& v0, f32x4& v1) {
    v0[0] = __uint_as_float(w.x << 16); v0[1] = __uint_as_float(w.x & 0xffff0000u); v0[2] = __uint_as_float(w.y << 16); v0[3] = __uint_as_float(w.y & 0xffff0000u);
    v1[0] = __uint_as_float(w.z << 16); v1[1] = __uint_as_float(w.z & 0xffff0000u); v1[2] = __uint_as_float(w.w << 16); v1[3] = __uint_as_float(w.w & 0xffff0000u); }
__device__ __forceinline__ float sigm(float x) { return __builtin_amdgcn_rcpf(1.0f + __builtin_amdgcn_exp2f(-1.4426950408889634f * x)); }
__device__ __forceinline__ f32x4 sigm4(f32x4 v) { f32x4 o; o[0] = sigm(v[0]); o[1] = sigm(v[1]); o[2] = sigm(v[2]); o[3] = sigm(v[3]); return o; }
__device__ __forceinline__ float sq4(f32x4 v) { return (v[0] * v[0] + v[1] * v[1]) + (v[2] * v[2] + v[3] * v[3]); }
struct EpiGen {
    static constexpr bool PERM = true, AFTER_DRAIN = false;
    int mode; int ldc; int midk;
    bf16_t* O;
    const bf16_t* aux;
    unsigned char* ws;
    __device__ __forceinline__ void mid(f32x4 (&acc)[2][2][4][2], const Unit& u, int wr, int wc, int fr, int fq) const {
        const int row0 = u.pm * BM + wr * 64 + fr, cw = wc * 32 + 8 * fq;
        const bf16_t* sga = (const bf16_t*)(ws + WS_SGA); const bf16_t* sgb = (const bf16_t*)(ws + WS_SGB);
#pragma unroll
        for (int ai = 0; ai < 2; ++ai)
#pragma unroll
        for (int mh = 0; mh < 2; ++mh) {
            u32x4 ga[2][2], gb[2][2];
#pragma unroll
            for (int ml = 0; ml < 2; ++ml)
#pragma unroll
                for (int bj = 0; bj < 2; ++bj) { const size_t off = (size_t)(row0 + ai * HALF + (2 * mh + ml) * 16) * DM_ + u.pn * BM + bj * HALF + cw; ga[ml][bj] = *(const u32x4*)(sga + off); gb[ml][bj] = *(const u32x4*)(sgb + off); }
#pragma unroll
            for (int ml = 0; ml < 2; ++ml)
#pragma unroll
                for (int bj = 0; bj < 2; ++bj) { f32x4 a0, a1, b0, b1; un8(ga[ml][bj], a0, a1); un8(gb[ml][bj], b0, b1); const int m = 2 * mh + ml;
#pragma unroll
                    for (int j = 0; j < 4; ++j) { acc[ai][bj][m][0][j] *= a0[j] * __builtin_amdgcn_rcpf(b0[j]); acc[ai][bj][m][1][j] *= a1[j] * __builtin_amdgcn_rcpf(b1[j]); } }
            asm volatile("" ::: "memory");
        }
    }
    __device__ __forceinline__ void operator()(const f32x4 (&acc)[2][2][4][2], const Unit& u, int wr, int wc, int fr, int fq) const {
        const int row0 = u.pm * BM + wr * 64 + fr, cw = wc * 32 + 8 * fq;
        const float* rs = (const float*)(ws + WS_RS); float* part = (float*)(ws + WS_PART);
        bf16_t *oq = (bf16_t*)(ws + WS_Q), *ok = (bf16_t*)(ws + WS_K), *ov = (bf16_t*)(ws + WS_V), *oga = (bf16_t*)(ws + WS_SGA), *ogb = (bf16_t*)(ws + WS_SGB);
        if (mode == EM_SWIGLU) {
            float r8[2][4];
#pragma unroll
            for (int ai = 0; ai < 2; ++ai)
#pragma unroll
                for (int m = 0; m < 4; ++m) r8[ai][m] = rs[row0 + ai * HALF + m * 16];
#pragma unroll
            for (int ai = 0; ai < 2; ++ai)
#pragma unroll
                for (int m = 0; m < 4; ++m) { const int row = row0 + ai * HALF + m * 16; const float r = r8[ai][m]; f32x4 o[2];
#pragma unroll
                    for (int n = 0; n < 2; ++n) { const f32x4 g = acc[ai][0][m][n] * r, up = acc[ai][1][m][n] * r; o[n] = g * sigm4(g) * up; }
                    st8(O + (size_t)row * FF + u.pn * HALF + cw, o[0], o[1]); }
        } else if (mode == EM_HSUM) {
#pragma unroll
            for (int ai = 0; ai < 2; ++ai)
#pragma unroll
                for (int m = 0; m < 4; ++m) { const int row = row0 + ai * HALF + m * 16; float ss = 0.f;
#pragma unroll
                    for (int bj = 0; bj < 2; ++bj) { const size_t off = (size_t)row * DM_ + u.pn * BM + bj * HALF + cw; const f32x4 v0 = acc[ai][bj][m][0], v1 = acc[ai][bj][m][1];
                        ss += sq4(v0) + sq4(v1); st8(O + off, v0, v1); }
                    ss += __shfl_xor(ss, 16); ss += __shfl_xor(ss, 32);
                    if (fq == 0) part[(size_t)row * 16 + u.pn * 4 + wc] = ss; }
        } else if (mode == EM_HYT) {
            f32x4 rc[2][2];
#pragma unroll
            for (int bj = 0; bj < 2; ++bj) { const int col = u.pn * BM + bj * HALF + cw; rc[bj][0] = *(const f32x4*)(rs + col); rc[bj][1] = *(const f32x4*)(rs + col + 4); }
#pragma unroll
            for (int bj = 0; bj < 2; ++bj) { const int col = u.pn * BM + bj * HALF + cw;
#pragma unroll
                for (int ai = 0; ai < 2; ++ai)
#pragma unroll
                    for (int m = 0; m < 4; ++m) { const int row = row0 + ai * HALF + m * 16; st8(O + (size_t)row * M + col, acc[ai][bj][m][0] * rc[bj][0], acc[ai][bj][m][1] * rc[bj][1]); } }
        } else if (mode == EM_QKVG) {
            const int pn = u.pn;
            float r8[2][4];
#pragma unroll
            for (int ai = 0; ai < 2; ++ai)
#pragma unroll
                for (int m = 0; m < 4; ++m) r8[ai][m] = rs[row0 + ai * HALF + m * 16];
#pragma unroll
            for (int ai = 0; ai < 2; ++ai)
#pragma unroll
                for (int m = 0; m < 4; ++m) { const int row = row0 + ai * HALF + m * 16; const float r = r8[ai][m];
#pragma unroll
                    for (int bj = 0; bj < 2; ++bj) { f32x4 v0 = acc[ai][bj][m][0] * r, v1 = acc[ai][bj][m][1] * r; const int ct = bj * HALF + cw;
                        if (pn < 2) st8(oq + (size_t)row * 512 + pn * BM + ct, v0, v1);
                        else if (pn == 2) st8((bj == 0 ? ok : ov) + (size_t)row * 128 + cw, v0, v1);
                        else if (pn < 7) st8(oga + (size_t)row * 1024 + (pn - 3) * BM + ct, sigm4(v0), sigm4(v1));
                        else st8(ogb + (size_t)row * 1024 + (pn - 7) * BM + ct, sigm4(v0), sigm4(v1)); } }
        } else {
#pragma unroll
            for (int ai = 0; ai < 2; ++ai)
#pragma unroll
            for (int mh = 0; mh < 2; ++mh) {
                u32x4 ga[2][2], pa[2][2]; float rg[2] = {1.f, 1.f};
                if (mode == EM_PLEG) { rg[0] = rs[row0 + ai * HALF + (2 * mh) * 16]; rg[1] = rs[row0 + ai * HALF + (2 * mh + 1) * 16]; }
                if (mode != EM_PLAIN) {
#pragma unroll
                    for (int ml = 0; ml < 2; ++ml)
#pragma unroll
                        for (int bj = 0; bj < 2; ++bj) { const size_t off = (size_t)(row0 + ai * HALF + (2 * mh + ml) * 16) * DM_ + u.pn * BM + bj * HALF + cw; ga[ml][bj] = *(const u32x4*)(aux + off);
                            if (mode == EM_MERGEB) pa[ml][bj] = *(const u32x4*)(O + off); }
                }
#pragma unroll
                for (int ml = 0; ml < 2; ++ml) { const int m = 2 * mh + ml; const int row = row0 + ai * HALF + m * 16; float ss = 0.f; const float r = rg[ml];
#pragma unroll
                    for (int bj = 0; bj < 2; ++bj) { const size_t off = (size_t)row * DM_ + u.pn * BM + bj * HALF + cw; f32x4 v0 = acc[ai][bj][m][0], v1 = acc[ai][bj][m][1];
                        if (mode != EM_PLAIN) { f32x4 g0, g1; un8(ga[ml][bj], g0, g1);
                            if (mode == EM_PLEG) { v0 = sigm4(v0 * r) * g0; v1 = sigm4(v1 * r) * g1; } else { v0 = v0 * g0; v1 = v1 * g1; } }
                        if (mode == EM_MERGEB) { f32x4 p0, p1; un8(pa[ml][bj], p0, p1); v0 = v0 + p0; v1 = v1 + p1; }
                        if (mode == EM_PLEG) ss += sq4(v0) + sq4(v1);
                        st8(O + off, v0, v1); }
                    if (mode == EM_PLEG) { ss += __shfl_xor(ss, 16); ss += __shfl_xor(ss, 32); if (fq == 0) part[(size_t)row * 16 + u.pn * 4 + wc] = ss; } }
                asm volatile("" ::: "memory");
            }
        }
    }
};
template <class Epi, class Sched, bool ALIGN_EPI = false, bool SP2 = false>
__device__ __forceinline__ void gemm_phase(PG8_LAS unsigned char* lds, const Gemm g, const Sched& S, const Epi& E) {
    int tid_o = threadIdx.x; asm volatile("" : "+v"(tid_o)); const int tid = tid_o, wid = __builtin_amdgcn_readfirstlane(tid >> 6), lane = tid & 63, wr = wid >> 2, wc = wid & 3, fr = lane & 15, fq = lane >> 4;
    const int K = g.K, nt = K / BK;
    unsigned voffA[2], voffB[2];
#pragma unroll
    for (int i = 0; i < 2; ++i) { int R, C; stage_rc(tid * 16 + i * 8192, R, C); const int Rb = Epi::PERM ? ((R & ~31) + perm32(R & 31)) : R;
        voffA[i] = (unsigned)(R * K + C) * 2u; voffB[i] = (unsigned)(Rb * K + C) * 2u; }
    const size_t kstep = (size_t)(BK * 2);
    const size_t hstep = (size_t)HALF * K * 2;
    const size_t tstep = 2 * hstep;
    const unsigned ldsw = (unsigned)wid * 1024u;
    const int aoff = lds_byte(wr * 64 + fr, fq * 8), boff = lds_byte(wc * 32 + fr, fq * 8);
#define PG8_SA(b, h) (((b) * 2 + (h)) * HTB)
#define PG8_SB(b, h) ((4 + (b) * 2 + (h)) * HTB)
#define PG8_STAGE(bufoff, gbase, voff) do { _Pragma("unroll") for (int _i = 0; _i < 2; ++_i) \
        __builtin_amdgcn_global_load_lds((const unsigned*)((const char*)(gbase) + (voff)[_i]), (PG8_LAS unsigned*)(lds + (bufoff) + ldsw + _i * 8192), 16, 0, 0); } while (0)
#define PG8_LDA(dst, b, h) do { _Pragma("unroll") for (int m = 0; m < 4; ++m) _Pragma("unroll") for (int k = 0; k < 2; ++k) dst[m][k] = *(const PG8_LAS bf16x8*)(lds + PG8_SA(b, h) + aoff + m * 2048 + k * 1024); } while (0)
#define PG8_LDB(dst, b, h) do { _Pragma("unroll") for (int n = 0; n < 2; ++n) _Pragma("unroll") for (int k = 0; k < 2; ++k) dst[n][k] = *(const PG8_LAS bf16x8*)(lds + PG8_SB(b, h) + boff + n * 2048 + k * 1024); } while (0)
#define PG8_MMA(ai, bj, At, Bt) do { __builtin_amdgcn_s_setprio(1); _Pragma("unroll") for (int m = 0; m < 4; ++m) _Pragma("unroll") for (int n = 0; n < 2; ++n) _Pragma("unroll") for (int k = 0; k < 2; ++k) \
        acc[ai][bj][m][n] = __builtin_amdgcn_mfma_f32_16x16x32_bf16(Bt[n][k], At[m][k], acc[ai][bj][m][n], 0, 0, 0); __builtin_amdgcn_s_setprio(0); } while (0)
#define PG8_WAIT_V(n) asm volatile("s_waitcnt vmcnt(" #n ")" ::: "memory")
#define PG8_WAIT_L(n) asm volatile("s_waitcnt lgkmcnt(" #n ")" ::: "memory")
#define PG8_BAR __builtin_amdgcn_s_barrier()
#define PG8_SCHED __builtin_amdgcn_sched_barrier(0)
    Unit cur, nxt; int ui = 0;
    if (!S.next(0, cur)) return;
    f32x4 acc[2][2][4][2];
#pragma unroll
    for (int a = 0; a < 2; ++a)
#pragma unroll
        for (int b = 0; b < 2; ++b)
#pragma unroll
            for (int m = 0; m < 4; ++m)
#pragma unroll
                for (int n = 0; n < 2; ++n) acc[a][b][m][n] = (f32x4){0.f, 0.f, 0.f, 0.f};
    bf16x8 At[4][2], B0[2][2], B1[2][2];
    const char* cA = (const char*)(cur.half ? g.A2 : g.A) + (size_t)cur.pm * tstep; const char* cB = (const char*)(cur.half ? g.Bt2 : g.Bt) + (size_t)cur.pn * tstep;
    S.a_ready(cur);
    if constexpr (SP2) {
        PG8_STAGE(PG8_SB(0, 0), cB, voffB); PG8_STAGE(PG8_SB(0, 1), cB + hstep, voffB); PG8_STAGE(PG8_SA(0, 0), cA, voffA); PG8_STAGE(PG8_SA(0, 1), cA + hstep, voffA);
        if (wr == 1) PG8_BAR;
        PG8_WAIT_V(2); PG8_BAR;
        PG8_STAGE(PG8_SB(1, 0), cB + kstep, voffB); PG8_STAGE(PG8_SA(1, 0), cA + kstep, voffA); PG8_STAGE(PG8_SB(1, 1), cB + hstep + kstep, voffB);
        PG8_WAIT_V(6); PG8_BAR;
    } else {
        PG8_STAGE(PG8_SB(0, 0), cB, voffB); PG8_STAGE(PG8_SA(0, 0), cA, voffA); PG8_STAGE(PG8_SB(0, 1), cB + hstep, voffB); PG8_STAGE(PG8_SA(0, 1), cA + hstep, voffA);
        if (wr == 1) PG8_BAR;
        PG8_WAIT_V(4); PG8_BAR;
        PG8_STAGE(PG8_SB(1, 0), cB + kstep, voffB); PG8_STAGE(PG8_SA(1, 0), cA + kstep, voffA); PG8_STAGE(PG8_SB(1, 1), cB + hstep + kstep, voffB);
        PG8_WAIT_V(6); PG8_BAR;
    }
    for (;;) {
        const bool has_next = S.next(ui + 1, nxt);
        const char* nA = has_next ? (const char*)(nxt.half ? g.A2 : g.A) + (size_t)nxt.pm * tstep : cA; const char* nB = has_next ? (const char*)(nxt.half ? g.Bt2 : g.Bt) + (size_t)nxt.pn * tstep : cB;
        for (int t = 0; t < nt; t += 2) {
            const bool last = (t == nt - 2);
            const char* a1 = cA + (size_t)(t + 1) * kstep;
            const char* a2 = last ? nA : cA + (size_t)(t + 2) * kstep; const char* b2 = last ? nB : cB + (size_t)(t + 2) * kstep;
            const char* a3 = a2 + kstep; const char* b3 = b2 + kstep;
            if (last && has_next) S.a_ready(nxt);
            if constexpr (SP2) {
            PG8_LDB(B0, 0, 0); PG8_LDB(B1, 0, 1); PG8_SCHED; PG8_LDA(At, 0, 0); PG8_STAGE(PG8_SA(1, 1), a1 + hstep, voffA);
            PG8_WAIT_V(8); PG8_WAIT_L(0); PG8_BAR; PG8_MMA(0, 0, At, B0); PG8_MMA(0, 1, At, B1); PG8_BAR; PG8_SCHED;
            PG8_LDA(At, 0, 1); PG8_STAGE(PG8_SB(0, 0), b2, voffB); PG8_STAGE(PG8_SB(0, 1), b2 + hstep, voffB); PG8_STAGE(PG8_SA(0, 0), a2, voffA);
            PG8_WAIT_V(8); PG8_WAIT_L(0); PG8_BAR; PG8_MMA(1, 0, At, B0); PG8_MMA(1, 1, At, B1); PG8_BAR; PG8_SCHED;
            PG8_LDB(B0, 1, 0); PG8_LDB(B1, 1, 1); PG8_SCHED; PG8_LDA(At, 1, 0); PG8_STAGE(PG8_SA(0, 1), a2 + hstep, voffA);
            PG8_WAIT_V(8); PG8_WAIT_L(0); PG8_BAR; PG8_MMA(0, 0, At, B0); PG8_MMA(0, 1, At, B1); PG8_BAR; PG8_SCHED;
            PG8_LDA(At, 1, 1); PG8_STAGE(PG8_SB(1, 0), b3, voffB); PG8_STAGE(PG8_SB(1, 1), b3 + hstep, voffB); PG8_STAGE(PG8_SA(1, 0), a3, voffA);
            PG8_WAIT_V(8); PG8_WAIT_L(0); PG8_BAR; PG8_MMA(1, 0, At, B0); PG8_MMA(1, 1, At, B1); PG8_BAR; PG8_SCHED;
            } else {
            PG8_LDB(B0, 0, 0); PG8_SCHED; PG8_LDA(At, 0, 0); PG8_STAGE(PG8_SA(1, 1), a1 + hstep, voffA);
            PG8_WAIT_L(8); PG8_BAR; PG8_WAIT_L(0); PG8_MMA(0, 0, At, B0); PG8_BAR; PG8_SCHED;
            PG8_LDB(B1, 0, 1); PG8_STAGE(PG8_SB(0, 0), b2, voffB);
            PG8_BAR; PG8_WAIT_L(0); PG8_MMA(0, 1, At, B1); PG8_BAR;
            PG8_LDA(At, 0, 1); PG8_STAGE(PG8_SA(0, 0), a2, voffA);
            PG8_BAR; PG8_WAIT_L(0); PG8_MMA(1, 0, At, B0); PG8_BAR; PG8_SCHED;
            PG8_STAGE(PG8_SB(0, 1), b2 + hstep, voffB);
            PG8_WAIT_V(6); PG8_BAR; PG8_MMA(1, 1, At, B1); PG8_BAR;
            PG8_LDB(B0, 1, 0); PG8_SCHED; PG8_LDA(At, 1, 0); PG8_STAGE(PG8_SA(0, 1), a2 + hstep, voffA);
            PG8_WAIT_L(8); PG8_BAR; PG8_WAIT_L(0); PG8_MMA(0, 0, At, B0); PG8_BAR; PG8_SCHED;
            PG8_LDB(B1, 1, 1); PG8_STAGE(PG8_SB(1, 0), b3, voffB);
            PG8_BAR; PG8_WAIT_L(0); PG8_MMA(0, 1, At, B1); PG8_BAR;
            PG8_LDA(At, 1, 1); PG8_STAGE(PG8_SA(1, 0), a3, voffA);
            PG8_BAR; PG8_WAIT_L(0); PG8_MMA(1, 0, At, B0); PG8_BAR; PG8_SCHED;
            PG8_STAGE(PG8_SB(1, 1), b3 + hstep, voffB);
            PG8_WAIT_V(6); PG8_BAR; PG8_MMA(1, 1, At, B1); PG8_BAR;
            }
        }
        if constexpr (ALIGN_EPI) { if (wr == 0) PG8_BAR; }
        const bool keep_acc = (E.midk != 0 && cur.half == 0);
        if constexpr (!Epi::AFTER_DRAIN) { if (keep_acc) E.mid(acc, cur, wr, wc, fr, fq); else E(acc, cur, wr, wc, fr, fq); S.done(cur); }
        if (!has_next) break;
        if (!keep_acc) {
#pragma unroll
        for (int a = 0; a < 2; ++a)
#pragma unroll
            for (int b = 0; b < 2; ++b)
#pragma unroll
                for (int m = 0; m < 4; ++m)
#pragma unroll
                    for (int n = 0; n < 2; ++n) acc[a][b][m][n] = (f32x4){0.f, 0.f, 0.f, 0.f};
        }
        cur = nxt; cA = nA; cB = nB; ++ui;
        if constexpr (ALIGN_EPI) { if (wr == 1) PG8_BAR; }
    }
    PG8_WAIT_V(0);
    if constexpr (!ALIGN_EPI) { if (wr == 0) PG8_BAR; }
    PG8_BAR;
    if constexpr (Epi::AFTER_DRAIN) { E.fused(acc, cur, wr, wc, fr, fq, lds, wid, lane); S.done(cur); }
#undef PG8_SA
#undef PG8_SB
#undef PG8_STAGE
#undef PG8_LDA
#undef PG8_LDB
#undef PG8_MMA
#undef PG8_WAIT_V
#undef PG8_WAIT_L
#undef PG8_BAR
#undef PG8_SCHED
}
}
namespace attn_body {
using bf16=__hip_bfloat16;
using bf16x8=__attribute__((ext_vector_type(8)))short;
using s16x4=__attribute__((ext_vector_type(4)))short;
using f32x16=__attribute__((ext_vector_type(16)))float;
using u32x4=__attribute__((ext_vector_type(4)))unsigned;
constexpr int BATCH=16,NHEAD=8,NKVH=2,SEQ=4096,D=64,DM=NHEAD*D,KP=NKVH*D;
constexpr int NW=8,QBLK=32,QB=QBLK*NW,KVBLK=64,NQB=SEQ/QB;
constexpr int ATTN_PITCH=DM, ATTN_UNIT_ROWS=QB;
__device__ __forceinline__ int crow(int r,int hi){return (r&3)+8*(r>>2)+4*hi;}
#define SBAR() __builtin_amdgcn_sched_barrier(0)
__device__ __forceinline__ void cmask(f32x16&p0,f32x16&p1,int jb,int qrel,int hi){
  const float NEG=-INFINITY; int kb=64*jb+4*hi;
  #pragma unroll
  for(int r=0;r<16;++r){int kv=kb+(r&3)+8*(r>>2); if(kv>qrel)p0[r]=NEG; if(kv+32>qrel)p1[r]=NEG;}
}

constexpr int NSLOT=3, SLOTB=8192;
constexpr int LDS_K=0, LDS_V=NSLOT*SLOTB, LDS_WS=2*NSLOT*SLOTB, LDS_OST=LDS_WS+NW*64*4, LDS_BYTES=LDS_OST+NW*4096;
constexpr float C2=0.125f*1.4426950408889634f;
__device__ __forceinline__ void glds16(const void*gsrc,unsigned lds_dst){unsigned keep;
  asm volatile("s_mov_b32 %0, m0\n\ts_mov_b32 m0, %2\n\ts_nop 0\n\tglobal_load_lds_dwordx4 %1, off\n\ts_mov_b32 m0, %0":"=&s"(keep):"v"(gsrc),"s"(lds_dst):"memory");}
__device__ __forceinline__ float max3f(float a,float b,float c){float r;asm("v_max3_f32 %0, %1, %2, %3":"=v"(r):"v"(a),"v"(b),"v"(c));return r;}
__device__ __forceinline__ float max2f(float a,float b){float r;asm("v_max_f32_e32 %0, %1, %2":"=v"(r):"v"(a),"v"(b));return r;}
__device__ __forceinline__ float fadd_s(float a,float b){float r;asm("v_add_f32_e32 %0, %1, %2":"=v"(r):"v"(a),"v"(b));return r;}
__device__ __forceinline__ float fsub_s(float a,float b){float r;asm("v_sub_f32_e32 %0, %1, %2":"=v"(r):"v"(a),"v"(b));return r;}
typedef float f32x2_t __attribute__((ext_vector_type(2))); typedef __bf16 bf16x2_t __attribute__((ext_vector_type(2)));
__device__ __forceinline__ unsigned cvtpk_s(float lo,float hi){f32x2_t v={lo,hi};bf16x2_t b=__builtin_convertvector(v,bf16x2_t);return __builtin_bit_cast(unsigned,b);}
#define WAIT_BAR(N) asm volatile("s_waitcnt vmcnt(" #N ") lgkmcnt(0)\n\ts_barrier":::"memory")

__device__ __forceinline__ void qkt(f32x16&p0,f32x16&p1,const char*Kslot,const bf16x8*qr,const f32x16&negm,int r32,int hi){
  const char*kb=Kslot+hi*1024+r32*16;
  #pragma unroll
  for(int d0=0;d0<4;++d0){
    const bf16x8 b0=*reinterpret_cast<const bf16x8*>(kb+d0*2048);
    const bf16x8 b1=*reinterpret_cast<const bf16x8*>(kb+d0*2048+512);
    if(d0==0){p0=__builtin_amdgcn_mfma_f32_32x32x16_bf16(b0,qr[0],negm,0,0,0);p1=__builtin_amdgcn_mfma_f32_32x32x16_bf16(b1,qr[0],negm,0,0,0);}
    else{p0=__builtin_amdgcn_mfma_f32_32x32x16_bf16(b0,qr[d0],p0,0,0,0);p1=__builtin_amdgcn_mfma_f32_32x32x16_bf16(b1,qr[d0],p1,0,0,0);}}
}
typedef __attribute__((address_space(3))) const char* lds_cptr;
typedef short v4i16_t __attribute__((ext_vector_type(4)));
__device__ __forceinline__ void kload8(bf16x8*kf,lds_cptr kp){
  kf[0]=*(const __attribute__((address_space(3))) bf16x8*)(kp);      kf[1]=*(const __attribute__((address_space(3))) bf16x8*)(kp+512);
  kf[2]=*(const __attribute__((address_space(3))) bf16x8*)(kp+2048); kf[3]=*(const __attribute__((address_space(3))) bf16x8*)(kp+2560);
  kf[4]=*(const __attribute__((address_space(3))) bf16x8*)(kp+4096); kf[5]=*(const __attribute__((address_space(3))) bf16x8*)(kp+4608);
  kf[6]=*(const __attribute__((address_space(3))) bf16x8*)(kp+6144); kf[7]=*(const __attribute__((address_space(3))) bf16x8*)(kp+6656);
}
__device__ __forceinline__ void kload2(bf16x8*kf,lds_cptr kp,int j){ kf[2*j]=*(const __attribute__((address_space(3))) bf16x8*)(kp+j*2048); kf[2*j+1]=*(const __attribute__((address_space(3))) bf16x8*)(kp+j*2048+512); }
__device__ __forceinline__ s16x4 vtr(lds_cptr p){ return __builtin_bit_cast(s16x4,__builtin_amdgcn_ds_read_tr16_b64_v4i16((__attribute__((address_space(3))) v4i16_t*)p)); }
__device__ __forceinline__ float rowmax(const f32x16&p0,const f32x16&p1){
  float a=max3f(p0[0],p0[1],p1[0]),b=max3f(p0[2],p0[3],p1[1]);a=max3f(a,p1[2],p1[3]);
  #pragma unroll
  for(int r=4;r<16;r+=4){a=max3f(a,p0[r],p0[r+1]);b=max3f(b,p0[r+2],p0[r+3]);a=max3f(a,p1[r],p1[r+1]);b=max3f(b,p1[r+2],p1[r+3]);}
  const float m=max2f(a,b);
  auto rr=__builtin_amdgcn_permlane32_swap(__float_as_uint(m),__float_as_uint(m),false,false);
  return max2f(__uint_as_float(rr[0]),__uint_as_float(rr[1]));
}
__device__ __forceinline__ void pv(f32x16*o,int vb,bf16x8 pa0,bf16x8 pa1,bf16x8 pa2,bf16x8 pa3){
  #pragma unroll
  for(int d0=0;d0<2;++d0){s16x4 lo[4],hi[4];
    #pragma unroll
    for(int ks=0;ks<4;++ks){
      asm volatile("ds_read_b64_tr_b16 %0,%1 offset:%c2":"=&v"(lo[ks]):"v"(vb),"i"(d0*4096+ks*1024):"memory");
      asm volatile("ds_read_b64_tr_b16 %0,%1 offset:%c2":"=&v"(hi[ks]):"v"(vb),"i"(d0*4096+ks*1024+512):"memory");}
    asm volatile("s_waitcnt lgkmcnt(0)":::"memory");SBAR();
    #define PK(k) (bf16x8){lo[k][0],lo[k][1],lo[k][2],lo[k][3],hi[k][0],hi[k][1],hi[k][2],hi[k][3]}
    o[d0]=__builtin_amdgcn_mfma_f32_32x32x16_bf16(pa0,PK(0),o[d0],0,0,0);
    o[d0]=__builtin_amdgcn_mfma_f32_32x32x16_bf16(pa1,PK(1),o[d0],0,0,0);
    o[d0]=__builtin_amdgcn_mfma_f32_32x32x16_bf16(pa2,PK(2),o[d0],0,0,0);
    o[d0]=__builtin_amdgcn_mfma_f32_32x32x16_bf16(pa3,PK(3),o[d0],0,0,0);
    #undef PK
  }
}

#ifndef ATTN_STORE16
#define ATTN_STORE16(p,v) (*(u32x4*)(p)=(v))
#endif
template<int THRL> __device__ __forceinline__ void attn_unit(int b,int h,int qb,const bf16*Q,const bf16*__restrict__ K,const bf16*__restrict__ V,bf16*O,char*shm){
  int tid_o=threadIdx.x; asm volatile("":"+v"(tid_o)); const int tid=tid_o,lane=tid&63,r32=lane&31,hi=lane>>5; const int wid=__builtin_amdgcn_readfirstlane(tid>>6);
  const long rowbase=(long)b*SEQ; const int q0=qb*QB;
  const bf16*Qw=Q+(rowbase+q0+wid*QBLK)*DM+h*D;
  const bf16*Kh=K+rowbase*KP+(h>>2)*D,*Vh=V+rowbase*KP+(h>>2)*D;
  const unsigned lds0=(unsigned)(uintptr_t)shm;
  float*wsf=(float*)(shm+LDS_WS)+wid*64;
  const bf16*ksrc=Kh+(long)lane*KP+wid*8;
  const bf16*vsrc=Vh+(long)(16*(wid&3)+(lane>>2))*KP+(wid>>2)*32+(lane&3)*8;
  const unsigned kdst=lds0+LDS_K+wid*1024, vdst=lds0+LDS_V+wid*1024;
  #define DMA_K(t,slot) glds16(ksrc+(long)(t)*KVBLK*KP,(unsigned)__builtin_amdgcn_readfirstlane(kdst+(slot)))
  #define DMA_V(t,slot) glds16(vsrc+(long)(t)*KVBLK*KP,(unsigned)__builtin_amdgcn_readfirstlane(vdst+(slot)))
  const int vb0=(int)(lds0+LDS_V)+((lane>>4)&1)*32+(lane&3)*8+(4*hi+((lane&15)>>2))*64;
  const char*Kbase=shm+LDS_K; bf16x8 kf[8];
  const lds_cptr shm3=(lds_cptr)shm; const lds_cptr kp0=shm3+LDS_K+hi*1024+r32*16; const lds_cptr vp0=shm3+LDS_V+((lane>>4)&1)*32+(lane&3)*8+(4*hi+((lane&15)>>2))*64;
  const int NT=SEQ/KVBLK;
  DMA_K(0,0);DMA_V(0,0);DMA_K(1,SLOTB);
  bf16x8 qr[4];
  #pragma unroll
  for(int d0=0;d0<4;++d0)qr[d0]=*reinterpret_cast<const bf16x8*>(&Qw[(long)r32*DM+d0*16+hi*8]);
  float mhat=0.f,l_reg=0.f;f32x16 o[2];o[0]=f32x16{};o[1]=f32x16{};f32x16 negm=f32x16{};asm volatile("":"+v"(negm));
  const int qrel=wid*QBLK+r32;
  #define CMASK(P0,P1,t) do{}while(0)
  bool resc=false;
  #define START(P0,P1) do{ const float rm=rowmax(P0,P1); resc=false; \
    { const float dl=rm; mhat=fadd_s(mhat,dl); \
      _Pragma("unroll") for(int r=0;r<16;++r){P0[r]=fsub_s(P0[r],dl);P1[r]=fsub_s(P1[r],dl);} \
      _Pragma("unroll") for(int r=0;r<16;++r)negm[r]=-mhat; asm volatile("":"+v"(negm)); } \
    _Pragma("unroll") for(int r=0;r<16;++r)P0[r]=__builtin_amdgcn_exp2f(P0[r]); }while(0)
  #define RESC() do{ if(resc){ asm volatile("s_waitcnt lgkmcnt(0)":::"memory"); \
      _Pragma("unroll") for(int d_=0;d_<2;++d_) _Pragma("unroll") for(int r=0;r<16;++r)o[d_][r]*=wsf[crow(r,hi)]; } }while(0)
  f32x16 pA0,pA1,pB0,pB1;
  int sl_prev=0,sl_cur=0,sl_next=SLOTB;
  #define ROT() do{sl_prev=sl_cur;sl_cur=sl_next;sl_next=(sl_next==(NSLOT-1)*SLOTB)?0:sl_next+SLOTB;}while(0)
  DMA_K(2,2*SLOTB);
  WAIT_BAR(3);
  qkt(pA0,pA1,Kbase,qr,negm,r32,hi);asm volatile("s_nop 15\n\ts_nop 7":"+v"(pA0),"+v"(pA1));CMASK(pA0,pA1,0);
  START(pA0,pA1);
  _Pragma("unroll") for(int r=0;r<16;++r)pA1[r]=__builtin_amdgcn_exp2f(pA1[r]);
  WAIT_BAR(0);
  DMA_K(3,0);DMA_V(1,SLOTB);
  ROT();
  kload8(kf,kp0+sl_cur);
  WAIT_BAR(2);
  s16x4 vlo[8],vhi[8]; u32x4 pw0,pw1,pw2,pw3;
  #define PKW(P,B) cvtpk_s(P[B],P[B+1])
  #define PAF(k) __builtin_bit_cast(bf16x8,pw##k)
  #define VFR(i) (bf16x8){vlo[i][0],vlo[i][1],vlo[i][2],vlo[i][3],vhi[i][0],vhi[i][1],vhi[i][2],vhi[i][3]}
  #define PIN(x) asm volatile("":"+v"(x))
  #define MX3(a,b,c) __builtin_fmaxf(__builtin_fmaxf((a),(b)),(c))
  #define GAPA(MF,A0,A1,A2,A3,W0,W1,PW) do{ MF; sacc+=A0; sacc+=A1; sacc+=A2; sacc+=A3; PIN(sacc); W0; W1; PIN(PW); SBAR(); }while(0)
  #define EX(v) __builtin_amdgcn_exp2f(v)
  #define GAPB(MF,X,B) do{ MF; X[B]=EX(X[B]); X[B+1]=EX(X[B+1]); X[B+2]=EX(X[B+2]); X[B+3]=EX(X[B+3]); PIN(X); SBAR(); }while(0)
  #define VRD(i) do{ vlo[i]=vtr(vp_+(((i)>>2)*4096+((i)&3)*1024)); vhi[i]=vtr(vp_+(((i)>>2)*4096+((i)&3)*1024+512)); }while(0)
  #define KRD(G,j) do{ if(G){ kload2(kf,kp0+sl_next,j); SBAR(); } }while(0)
  #define STEP(C0,C1,P0,P1,t,GK,GV,GL) do{ SBAR(); \
    const lds_cptr vp_=vp0+sl_prev; \
    VRD(0); SBAR(); float sacc=(P0[0]+P0[1]); \
    GAPA(C0=__builtin_amdgcn_mfma_f32_32x32x16_bf16(kf[0],qr[0],negm,0,0,0), P0[2],P0[3],P0[4],P0[5],     pw0[0]=PKW(P0,0), pw0[1]=PKW(P0,2), pw0); \
    VRD(4); SBAR(); GAPA(C1=__builtin_amdgcn_mfma_f32_32x32x16_bf16(kf[1],qr[0],negm,0,0,0), P0[6],P0[7],P0[8],P0[9],     pw0[2]=PKW(P0,4), pw0[3]=PKW(P0,6), pw0); \
    VRD(1); SBAR(); GAPA(C0=__builtin_amdgcn_mfma_f32_32x32x16_bf16(kf[2],qr[1],C0,0,0,0),   P0[10],P0[11],P0[12],P0[13], pw1[0]=PKW(P0,8), pw1[1]=PKW(P0,10), pw1); \
    VRD(5); SBAR(); GAPA(C1=__builtin_amdgcn_mfma_f32_32x32x16_bf16(kf[3],qr[1],C1,0,0,0),   P0[14],P0[15],P1[0],P1[1],   pw1[2]=PKW(P0,12),pw1[3]=PKW(P0,14), pw1); \
    VRD(2); SBAR(); GAPA(C0=__builtin_amdgcn_mfma_f32_32x32x16_bf16(kf[4],qr[2],C0,0,0,0),   P1[2],P1[3],P1[4],P1[5],     pw2[0]=PKW(P1,0), pw2[1]=PKW(P1,2), pw2); \
    VRD(6); SBAR(); GAPA(C1=__builtin_amdgcn_mfma_f32_32x32x16_bf16(kf[5],qr[2],C1,0,0,0),   P1[6],P1[7],P1[8],P1[9],     pw2[2]=PKW(P1,4), pw2[3]=PKW(P1,6), pw2); \
    VRD(3); SBAR(); GAPA(C0=__builtin_amdgcn_mfma_f32_32x32x16_bf16(kf[6],qr[3],C0,0,0,0),   P1[10],P1[11],P1[12],P1[13], pw3[0]=PKW(P1,8), pw3[1]=PKW(P1,10), pw3); \
    VRD(7); SBAR(); GAPA(C1=__builtin_amdgcn_mfma_f32_32x32x16_bf16(kf[7],qr[3],C1,0,0,0),   P1[14],P1[15],0.f,0.f,       pw3[2]=PKW(P1,12),pw3[3]=PKW(P1,14), pw3); \
    l_reg+=sacc; \
    if(GK){DMA_K((t)+3,sl_cur);} if(GV){DMA_V((t)+1,sl_next);} \
    CMASK(C0,C1,t); \
    { float a=MX3(C0[0],C0[1],C1[0]),b=MX3(C0[2],C0[3],C1[1]); a=MX3(a,C1[2],C1[3]); \
      _Pragma("unroll") for(int r=4;r<16;r+=4){a=MX3(a,C0[r],C0[r+1]);b=MX3(b,C0[r+2],C0[r+3]);a=MX3(a,C1[r],C1[r+1]);b=MX3(b,C1[r+2],C1[r+3]);} \
      float rm=__builtin_fmaxf(a,b); { auto rr=__builtin_amdgcn_permlane32_swap(__float_as_uint(rm),__float_as_uint(rm),false,false); rm=__builtin_fmaxf(__uint_as_float(rr[0]),__uint_as_float(rr[1])); } \
      resc=false; \
      if(__builtin_expect(__any(rm>(float)THRL),0)){ const float dl=__builtin_fmaxf(rm,0.f); mhat+=dl; \
        _Pragma("unroll") for(int r=0;r<16;++r){C0[r]-=dl;C1[r]-=dl;} \
        _Pragma("unroll") for(int r=0;r<16;++r)negm[r]=-mhat; asm volatile("":"+v"(negm)); \
        const float f=__builtin_amdgcn_exp2f(-dl); l_reg*=f; if(hi==0)wsf[r32]=f; resc=true; } } \
    SBAR(); \
    GAPB(o[0]=__builtin_amdgcn_mfma_f32_32x32x16_bf16(PAF(0),VFR(0),o[0],0,0,0), C0,0); \
    GAPB(o[1]=__builtin_amdgcn_mfma_f32_32x32x16_bf16(PAF(0),VFR(4),o[1],0,0,0), C0,4); \
    KRD(GL,0); GAPB(o[0]=__builtin_amdgcn_mfma_f32_32x32x16_bf16(PAF(1),VFR(1),o[0],0,0,0), C0,8); \
    KRD(GL,1); GAPB(o[1]=__builtin_amdgcn_mfma_f32_32x32x16_bf16(PAF(1),VFR(5),o[1],0,0,0), C0,12); \
    KRD(GL,2); GAPB(o[0]=__builtin_amdgcn_mfma_f32_32x32x16_bf16(PAF(2),VFR(2),o[0],0,0,0), C1,0); \
    KRD(GL,3); GAPB(o[1]=__builtin_amdgcn_mfma_f32_32x32x16_bf16(PAF(2),VFR(6),o[1],0,0,0), C1,4); \
    GAPB(o[0]=__builtin_amdgcn_mfma_f32_32x32x16_bf16(PAF(3),VFR(3),o[0],0,0,0), C1,8); \
    GAPB(o[1]=__builtin_amdgcn_mfma_f32_32x32x16_bf16(PAF(3),VFR(7),o[1],0,0,0), C1,12); \
    }while(0)
  int t=1;
  #undef CMASK
  #define CMASK(P0,P1,t) do{}while(0)
  for(;t+5<NT;t+=2){
    STEP(pB0,pB1,pA0,pA1,t,true,true,true);     WAIT_BAR(2); RESC(); ROT();
    STEP(pA0,pA1,pB0,pB1,t+1,true,true,true);   WAIT_BAR(2); RESC(); ROT();
  }
  #undef CMASK
  #define CMASK(P0,P1,t) do{}while(0)
  #define ENDW(tt) do{ if((tt)+3<NT){WAIT_BAR(2);} else if((tt)+2<NT){WAIT_BAR(1);} else {WAIT_BAR(0);} }while(0)
  for(;t+1<NT;t+=2){
    STEP(pB0,pB1,pA0,pA1,t,(t+3<NT),(t+1<NT),(t+1<NT));       ENDW(t);   RESC(); ROT();
    STEP(pA0,pA1,pB0,pB1,t+1,(t+4<NT),(t+2<NT),(t+2<NT));     ENDW(t+1); RESC(); ROT();
  }
  STEP(pB0,pB1,pA0,pA1,NT-1,false,false,false); RESC();
  { float sacc=pB0[0]+pB0[1]; _Pragma("unroll") for(int r=2;r<16;++r)sacc+=pB0[r]; _Pragma("unroll") for(int r=0;r<16;++r)sacc+=pB1[r]; l_reg+=sacc;
    pw0=(u32x4){PKW(pB0,0),PKW(pB0,2),PKW(pB0,4),PKW(pB0,6)};pw1=(u32x4){PKW(pB0,8),PKW(pB0,10),PKW(pB0,12),PKW(pB0,14)};pw2=(u32x4){PKW(pB1,0),PKW(pB1,2),PKW(pB1,4),PKW(pB1,6)};pw3=(u32x4){PKW(pB1,8),PKW(pB1,10),PKW(pB1,12),PKW(pB1,14)};
    SBAR(); pv(o,vb0+sl_cur,PAF(0),PAF(1),PAF(2),PAF(3)); }
  #undef PKW
  #undef PAF
  #undef VFR
  #undef PIN
  #undef MX3
  #undef GAPA
  #undef GAPB
  #undef EX
  #undef VRD
  #undef KRD
  #undef STEP
  #undef ENDW
  {auto rr=__builtin_amdgcn_permlane32_swap(__float_as_uint(l_reg),__float_as_uint(l_reg),false,false);l_reg=__uint_as_float(rr[0])+__uint_as_float(rr[1]);}
  if(hi==0)wsf[32+r32]=l_reg;asm volatile("s_waitcnt lgkmcnt(0)":::"memory");
  float rli[16];
  #pragma unroll
  for(int r=0;r<16;++r)rli[r]=__builtin_amdgcn_rcpf(wsf[32+crow(r,hi)]);
  bf16*Ow=O+(rowbase+q0+wid*QBLK)*DM+h*D;
  { bf16*stg=(bf16*)(shm+LDS_OST)+wid*2048;
    #pragma unroll
    for(int r=0;r<16;++r){const int orow=crow(r,hi);
      #pragma unroll
      for(int d0=0;d0<2;++d0)stg[orow*64+d0*32+r32]=__float2bfloat16(o[d0][r]*rli[r]);}
    asm volatile("s_waitcnt lgkmcnt(0)":::"memory");
    #pragma unroll
    for(int i=0;i<4;++i){const int row=i*8+(lane>>3),ch=lane&7; const u32x4 v=*(const u32x4*)(stg+row*64+ch*8); ATTN_STORE16(Ow+(long)row*DM+ch*8,v);} }
  asm volatile("s_waitcnt lgkmcnt(0)\n\ts_barrier":::"memory");
  #undef DMA_K
  #undef DMA_V
  #undef CMASK
  #undef START
  #undef RESC
  #undef ROT
}
constexpr int ATTN_LDS_BYTES=LDS_BYTES;
struct AttnTensors { const bf16* Q; const bf16* K; const bf16* V; bf16* O; };
struct AttnUnit { int bh; int qb; };
struct StaticOrder {
  int vcu, G;
  __device__ __forceinline__ explicit StaticOrder(int grid,int block):vcu((grid%8==0)?(block%8)*(grid/8)+block/8:block),G(grid){}
  __device__ __forceinline__ bool next(int i,AttnUnit&u)const{ const int idx=i*G+vcu; if(idx>=BATCH*NHEAD*NQB)return false; const int pair=idx/(4*NQB), r=idx%(4*NQB); u.bh=(pair>>1)*NHEAD+(pair&1)*4+r/NQB; u.qb=r%NQB; return true; }
  __device__ __forceinline__ void a_ready(const AttnUnit&)const{}
  __device__ __forceinline__ void done(const AttnUnit&)const{}
};
template<class Sched,int THRL=8> __device__ __forceinline__ void attn_phase(char*lds,const AttnTensors&T,const Sched&S){
  AttnUnit u;
  for(int i=0;S.next(i,u);++i){ S.a_ready(u); attn_unit<THRL>(u.bh/NHEAD,u.bh%NHEAD,u.qb,T.Q,T.K,T.V,T.O,lds); S.done(u); }
}
#undef SBAR
#undef WAIT_BAR
}
#define GAS __attribute__((address_space(1)))
#define LAS __attribute__((address_space(3)))
typedef unsigned short bf16;
typedef unsigned v4u __attribute__((ext_vector_type(4)));
typedef unsigned v2u __attribute__((ext_vector_type(2)));
typedef float f32x4 __attribute__((ext_vector_type(4)));
typedef float f32x2 __attribute__((ext_vector_type(2)));
typedef short bf16x8 __attribute__((ext_vector_type(8)));
typedef bf16x8 bf16x8_u2 __attribute__((aligned(2)));
constexpr int NWAVES = 8, NTHR = 512;
constexpr int LDS_BYTES = 161792;
constexpr int ZS = 4496, ZO = 192;
constexpr int HY_F_OFF = 16 * ZS * 2;
constexpr int HY_RED_OFF = HY_F_OFF + 16384;
constexpr int BARST_OFF = 161280;
constexpr size_t CTL_ZERO_BYTES = 16384;

__device__ __forceinline__ unsigned f2bf(float f) { unsigned u = __builtin_bit_cast(unsigned, f); return (u + 0x7fffu + ((u >> 16) & 1u)) >> 16; }
__device__ __forceinline__ unsigned pk2(float lo, float hi) { return f2bf(lo) | (f2bf(hi) << 16); }
__device__ __forceinline__ float bflo(unsigned w) { return __uint_as_float(w << 16); }
__device__ __forceinline__ float bfhi(unsigned w) { return __uint_as_float(w & 0xffff0000u); }
__device__ __forceinline__ float bf1(bf16 h) { return __uint_as_float((unsigned)h << 16); }
__device__ __forceinline__ float wave_sum(float v) {
#pragma unroll
    for (int o = 1; o < 64; o <<= 1) v += __shfl_xor(v, o);
    return v;
}
__device__ __forceinline__ float sq4v(f32x4 v) { return (v[0] * v[0] + v[1] * v[1]) + (v[2] * v[2] + v[3] * v[3]); }
#define LDS_WAIT() asm volatile("s_waitcnt lgkmcnt(0)" ::: "memory")

#define XB_TMO      128
#define XB_XCNT(j)  (256  + 64 * (j))
#define XB_XSUB(j)  (1280 + 64 * (j))
#define XB_XGEN(j)  (2304 + 64 * (j))
#define XB_TOP      3328
#define XB_TOPGEN   3392
#define XCD_BAR_WORDS 3456
#define XB_SPIN_CAP (1u << 18)

__device__ __forceinline__ unsigned xb_ld(unsigned* p)              { return __hip_atomic_load(p, __ATOMIC_RELAXED, __HIP_MEMORY_SCOPE_AGENT); }
__device__ __forceinline__ unsigned xb_add(unsigned* p, unsigned v) { return __hip_atomic_fetch_add(p, v, __ATOMIC_RELAXED, __HIP_MEMORY_SCOPE_AGENT); }
__device__ __forceinline__ unsigned xb_xcc_id() { return (unsigned)__builtin_amdgcn_s_getreg((3 << 11) | 20) & 0xFu; }
#define XB_SPIN(cond, bar) do { unsigned _sp = 0; while (cond) { __builtin_amdgcn_s_sleep(1); \
    if ((++_sp & 255u) == 0u) { if (xb_ld(&(bar)[XB_TMO])) break; if (_sp > XB_SPIN_CAP) { atomicAdd(&(bar)[XB_TMO], 1u); break; } } } } while (0)

struct XcdBarrier {
    unsigned* bar; unsigned x;
    volatile LAS unsigned* st;
};

__device__ __forceinline__ XcdBarrier xcd_barrier_post(unsigned* bar, volatile LAS unsigned* st) {
    XcdBarrier b; b.bar = bar; b.x = xb_xcc_id(); b.st = st;
    if (threadIdx.x == 0) (void)xb_add(&bar[XB_XCNT(b.x)], 1u);
    return b;
}
__device__ __forceinline__ void xcd_barrier_complete(unsigned* bar, unsigned x, unsigned& nloc, unsigned& nx) {
    const unsigned G = gridDim.x * gridDim.y * gridDim.z;
    unsigned sum, cnt, mine, sp = 0u;
    for (;;) {
        sum = 0u; cnt = 0u; mine = 0u;
#pragma unroll
        for (unsigned j = 0; j < 16; ++j) { const unsigned c = xb_ld(&bar[XB_XCNT(j)]); sum += c; cnt += (c > 0u) ? 1u : 0u; mine = (j == x) ? c : mine; }
        if (sum == G) break;
        __builtin_amdgcn_s_sleep(1);
        if ((++sp & 255u) == 0u) { if (xb_ld(&bar[XB_TMO])) break; if (sp > XB_SPIN_CAP) { atomicAdd(&bar[XB_TMO], 1u); break; } }
    }
    nloc = mine > 0u ? mine : 1u; nx = cnt > 0u ? cnt : 1u;
}

__device__ __forceinline__ void xcd_barrier(const XcdBarrier& b) {
    asm volatile("s_waitcnt vmcnt(0)" ::: "memory");
    __syncthreads();
    if (threadIdx.x == 0) {
        unsigned* bar = b.bar;
        __builtin_amdgcn_s_waitcnt(0);
        unsigned nloc = b.st[0], nx = b.st[1];
        if (nloc == 0u) { xcd_barrier_complete(bar, b.x, nloc, nx); b.st[0] = nloc; b.st[1] = nx; }
        const unsigned old = xb_add(&bar[XB_XSUB(b.x)], 1u);
        const unsigned gen = old / nloc;
        if (old + 1u == (gen + 1u) * nloc) {
            __builtin_amdgcn_fence(__ATOMIC_RELEASE, "agent");
            asm volatile("s_waitcnt vmcnt(0)" ::: "memory");
            const unsigned og = xb_add(&bar[XB_TOP], 1u);
            const unsigned tg = og / nx;
            if (og + 1u == (tg + 1u) * nx) xb_add(&bar[XB_TOPGEN], 1u);
            else XB_SPIN(xb_ld(&bar[XB_TOPGEN]) == tg, bar);
            __builtin_amdgcn_fence(__ATOMIC_ACQUIRE, "agent");
            xb_add(&bar[XB_XGEN(b.x)], 1u);
            asm volatile("s_waitcnt vmcnt(0)" ::: "memory");
        } else {
            XB_SPIN(xb_ld(&bar[XB_XGEN(b.x)]) == gen, bar);
            __builtin_amdgcn_fence(__ATOMIC_ACQUIRE, "agent");
            asm volatile("s_waitcnt vmcnt(0)" ::: "memory");
        }
    }
    __syncthreads();
}

struct Frame { LAS unsigned char* lds; int tid, lane, wave, vcu, G; };

__device__ __forceinline__ void transpose_item(const float* W, int K, int N, bf16* WT, int grp, int stride, int off, const float* g, LAS float* scr, int item, int lane) {
    const int nblk = N / 32, kb = item / nblk, nb = item % nblk, k0 = 64 * kb, n0 = 32 * nb;
#pragma unroll 8
    for (int i = 0; i < 32; ++i) { const int kk = 2 * i + (lane >> 5); float v = W[(size_t)(k0 + kk) * N + n0 + (lane & 31)]; if (g) v *= g[k0 + kk]; scr[kk * 33 + (lane & 31)] = v; }
    LDS_WAIT(); asm volatile("" ::: "memory");
    const int c = lane & 7;
#pragma unroll
    for (int j = 0; j < 4; ++j) { const int n = (lane >> 3) + 8 * j; const LAS float* s = scr + (8 * c) * 33 + n; const int ng = n0 + n, row = (ng / grp) * stride + off + (ng % grp);
        v4u o; o.x = pk2(s[0 * 33], s[1 * 33]); o.y = pk2(s[2 * 33], s[3 * 33]); o.z = pk2(s[4 * 33], s[5 * 33]); o.w = pk2(s[6 * 33], s[7 * 33]);
        *(v4u*)(WT + (size_t)row * K + k0 + 8 * c) = o; }
    LDS_WAIT(); asm volatile("" ::: "memory");
}

struct Args { const float* in[35]; float* out; unsigned char* ws; int step_lo, step_hi; };
#define CAS __attribute__((address_space(4)))
__device__ __forceinline__ const float* karg_in(int k) { CAS const char* ka = (CAS const char*)__builtin_amdgcn_kernarg_segment_ptr(); asm volatile("" : "+s"(ka)); typedef const float* cfp_t; return *(CAS const cfp_t*)(ka + 8 * k); }
__device__ __forceinline__ unsigned char* karg_ws() { CAS const char* ka = (CAS const char*)__builtin_amdgcn_kernarg_segment_ptr(); asm volatile("" : "+s"(ka)); typedef unsigned char* ucp_t; return *(CAS const ucp_t*)(ka + 288); }
__device__ __forceinline__ float* karg_out() { CAS const char* ka = (CAS const char*)__builtin_amdgcn_kernarg_segment_ptr(); asm volatile("" : "+s"(ka)); typedef float* fp_t; return *(CAS const fp_t*)(ka + 280); }
#define IN(k) karg_in(k)

__device__ __forceinline__ void prologue(const Frame& F) {
    unsigned char* ws = karg_ws();
    LAS float* scr = (LAS float*)(F.lds + F.wave * 16384);
    const int gw = F.vcu * NWAVES + F.wave, NGW = F.G * NWAVES, lane = F.lane;
    constexpr int I_G = (DM_ / 64) * (FF / 32), I_D = (FF / 64) * (DM_ / 32), I_IN = (DM_ / 64) * (INC / 32), I_HO = (HYW / 64) * (DM_ / 32), I_O = (DM_ / 64) * (DM_ / 32), I_PP = (PLE / 64) * (DM_ / 32);
    constexpr int NITEMS = 4 * I_G + 2 * I_D + I_IN + 2 * I_HO + 2 * I_O + I_PP;
    const int BIGN = 1 << 30;
    for (int it = gw; it < NITEMS; it += NGW) {
        int r = it;
        if (r < I_G) { transpose_item(IN(4), DM_, FF, (bf16*)(ws + WS_GU1), 128, 256, 0, IN(2), scr, r, lane); continue; } r -= I_G;
        if (r < I_G) { transpose_item(IN(5), DM_, FF, (bf16*)(ws + WS_GU1), 128, 256, 128, IN(2), scr, r, lane); continue; } r -= I_G;
        if (r < I_D) { transpose_item(IN(6), FF, DM_, (bf16*)(ws + WS_D1), BIGN, 0, 0, nullptr, scr, r, lane); continue; } r -= I_D;
        if (r < I_IN) { transpose_item(IN(9), DM_, INC, (bf16*)(ws + WS_IN), BIGN, 0, 0, IN(7), scr, r, lane); continue; } r -= I_IN;
        if (r < I_HO) { transpose_item(IN(23), HYW, DM_, (bf16*)(ws + WS_HYO), BIGN, 0, 0, nullptr, scr, r, lane); continue; } r -= I_HO;
        if (r < I_HO) { transpose_item(IN(24), HYW, DM_, (bf16*)(ws + WS_ATO), BIGN, 0, 0, nullptr, scr, r, lane); continue; } r -= I_HO;
        if (r < I_O) { transpose_item(IN(25), DM_, DM_, (bf16*)(ws + WS_OUT), BIGN, 0, 0, nullptr, scr, r, lane); continue; } r -= I_O;
        if (r < I_G) { transpose_item(IN(28), DM_, FF, (bf16*)(ws + WS_GU2), 128, 256, 0, IN(26), scr, r, lane); continue; } r -= I_G;
        if (r < I_G) { transpose_item(IN(29), DM_, FF, (bf16*)(ws + WS_GU2), 128, 256, 128, IN(26), scr, r, lane); continue; } r -= I_G;
        if (r < I_D) { transpose_item(IN(30), FF, DM_, (bf16*)(ws + WS_D2), BIGN, 0, 0, nullptr, scr, r, lane); continue; } r -= I_D;
        if (r < I_O) { transpose_item(IN(33), DM_, DM_, (bf16*)(ws + WS_PG), BIGN, 0, 0, IN(31), scr, r, lane); continue; } r -= I_O;
        transpose_item(IN(34), PLE, DM_, (bf16*)(ws + WS_PP), BIGN, 0, 0, nullptr, scr, r, lane);
    }
    { const float* x = IN(0); bf16* xb = (bf16*)(ws + WS_XB); float* rs = (float*)(ws + WS_RS);
      for (int row0 = gw; row0 < M; row0 += 2 * NGW) { f32x4 v[2][4];
#pragma unroll
          for (int u = 0; u < 2; ++u) { const int row = (row0 + u * NGW < M) ? row0 + u * NGW : row0; const f32x4* xr = (const f32x4*)(x + (size_t)row * DM_) + lane;
#pragma unroll
              for (int j = 0; j < 4; ++j) v[u][j] = xr[64 * j]; }
#pragma unroll
          for (int u = 0; u < 2; ++u) { const int row = row0 + u * NGW;
              if (row < M) { v2u* o8 = (v2u*)(xb + (size_t)row * DM_) + lane; float ss = 0.f;
#pragma unroll
                  for (int j = 0; j < 4; ++j) { v2u o; o.x = pk2(v[u][j][0], v[u][j][1]); o.y = pk2(v[u][j][2], v[u][j][3]); o8[64 * j] = o;
                      f32x4 xq; xq[0] = bflo(o.x); xq[1] = bfhi(o.x); xq[2] = bflo(o.y); xq[3] = bfhi(o.y); ss += sq4v(xq); }
                  ss = wave_sum(ss); if (lane == 0) rs[row] = 1.0f / sqrtf(ss * (1.0f / DM_) + EPS); } } } }
    { const float *w1 = IN(12), *b1 = IN(13), *f1 = IN(14), *w2 = IN(15), *b2 = IN(16), *f2 = IN(17); float* h2 = (float*)(ws + WS_H2);
      for (int t = gw; t < SEQ; t += NGW) {
          const float tl = (float)t * (1.0f / (float)(SEQ - 1)); const float wv = (float)(2.0 * 3.14159265358979323846 / SEQ) * (float)t;
          float z = 0.f;
          if (lane == 0) z = tl; else if (lane <= 32) { const int bi = (lane - 1) & 15; const float band = 1e-4f + (float)bi * ((15.0f - 1e-4f) / 15.0f); const float ang = wv * band; z = (lane <= 16) ? cosf(ang) : -sinf(ang); }
          float acc = b1[lane];
          for (int i = 0; i < 33; ++i) acc += __shfl(z, i) * w1[i * 64 + lane];
          const float h1 = sinf(f1[lane] * acc);
          float acc2 = b2[lane];
          for (int i = 0; i < 64; ++i) acc2 += __shfl(h1, i) * w2[i * 64 + lane];
          h2[t * 64 + lane] = sinf(f2[lane] * acc2); } }
    { f32x2* rope = (f32x2*)(ws + WS_ROPE);
      for (int idx = (F.vcu * NTHR + F.tid); idx < SEQ * 32; idx += F.G * NTHR) { const int t = idx >> 5, i = idx & 31; const float pos = (i < 16) ? (float)(t >> 6) : (float)(t & 63);
          const float inv = powf(10000.0f, -(float)(2 * (i & 15)) / 32.0f); const float ang = pos * inv; rope[idx] = (f32x2){cosf(ang), sinf(ang)}; } }
}

__device__ __forceinline__ void filter_cols(const Frame& F) {
    unsigned char* ws_ = karg_ws();
    const float* h2 = (const float*)(ws_ + WS_H2); const float* w3 = IN(18); const float* dl = IN(19); bf16* filt = (bf16*)(ws_ + WS_FILT);
    LAS float* sw = (LAS float*)F.lds; LAS float* red = sw + 128;
    for (int pr = blockIdx.x; pr < 2 * HYW; pr += F.G) {
        const int o = pr / HYW, c = pr % HYW, colf = o * 2 * HYW + c, colb = colf + HYW;
        if (F.tid < 128) sw[F.tid] = w3[(size_t)(F.tid & 63) * (4 * HYW) + (F.tid < 64 ? colf : colb)];
        __syncthreads();
        const float df = fabsf(dl[colf]), db = fabsf(dl[colb]);
        float hf[8], hb[8]; float s = 0.f;
#pragma unroll
        for (int i = 0; i < 8; ++i) { const int t = F.tid + NTHR * i; const f32x4* row = (const f32x4*)(h2 + (size_t)t * 64); float af = 0.f, ab = 0.f;
#pragma unroll
            for (int j = 0; j < 16; ++j) { const f32x4 v = row[j]; af += v[0] * sw[4 * j] + v[1] * sw[4 * j + 1] + v[2] * sw[4 * j + 2] + v[3] * sw[4 * j + 3];
                ab += v[0] * sw[64 + 4 * j] + v[1] * sw[64 + 4 * j + 1] + v[2] * sw[64 + 4 * j + 2] + v[3] * sw[64 + 4 * j + 3]; }
            const float tl = (float)t * (1.0f / (float)(SEQ - 1)); hf[i] = af * expf(-tl * df); hb[i] = ab * expf(-tl * db);
            s += (t == 0) ? fabsf(hf[i] + hb[i]) : (fabsf(hf[i]) + fabsf(hb[i]));  asm volatile("" ::: "memory"); }
        s = wave_sum(s); if (F.lane == 0) red[F.wave] = s;
        __syncthreads();
        float tot = 0.f;
#pragma unroll
        for (int w = 0; w < NWAVES; ++w) tot += red[w];
        const float inv = 1.0f / tot; bf16* Fp = filt + (size_t)pr * 8192;
#pragma unroll
        for (int i = 0; i < 8; ++i) { const int t = F.tid + NTHR * i;
            if (t == 0) { Fp[4095] = (bf16)f2bf((hf[i] + hb[i]) * inv); Fp[8191] = 0; }
            else { Fp[4095 - t] = (bf16)f2bf(hf[i] * inv); Fp[4095 + t] = (bf16)f2bf(hb[i] * inv); } }
        __syncthreads();
    }
}

__device__ __forceinline__ void elem_pass(const Frame& F, bf16* xb, const bf16* hb, const float* part, const float* gpost, float scale, float* xout, float* rsout, bool last) {
    const int gw = F.vcu * NWAVES + F.wave, NGW = F.G * NWAVES, lane = F.lane;
    f32x4 g[4];
#pragma unroll
    for (int j = 0; j < 4; ++j) g[j] = ((const f32x4*)gpost)[lane + 64 * j];
    for (int row0 = gw; row0 < M; row0 += 2 * NGW) {
        v2u xw[2][4], hw[2][4]; float pv[2];
#pragma unroll
        for (int u = 0; u < 2; ++u) { const int row = (row0 + u * NGW < M) ? row0 + u * NGW : row0;
            pv[u] = (lane < 16) ? part[(size_t)row * 16 + lane] : 0.f;
            const v2u* xr = (const v2u*)(xb + (size_t)row * DM_) + lane; const v2u* hr = (const v2u*)(hb + (size_t)row * DM_) + lane;
#pragma unroll
            for (int j = 0; j < 4; ++j) { xw[u][j] = xr[64 * j]; hw[u][j] = __builtin_nontemporal_load(hr + 64 * j); } }
#pragma unroll
        for (int u = 0; u < 2; ++u) { const int row = row0 + u * NGW;
            if (row < M) {
                const float rh = scale / sqrtf(wave_sum(pv[u]) * (1.0f / DM_) + EPS);
                v2u* xr = (v2u*)(xb + (size_t)row * DM_) + lane; f32x4* xo = (f32x4*)(xout + (size_t)row * DM_) + lane; float ss = 0.f;
#pragma unroll
                for (int j = 0; j < 4; ++j) { const v2u xv = xw[u][j], h = hw[u][j]; f32x4 x, hv;
                    x[0] = bflo(xv.x); x[1] = bfhi(xv.x); x[2] = bflo(xv.y); x[3] = bfhi(xv.y); hv[0] = bflo(h.x); hv[1] = bfhi(h.x); hv[2] = bflo(h.y); hv[3] = bfhi(h.y);
                    const f32x4 xn = x + hv * g[j] * rh;
                    if (last) __builtin_nontemporal_store(xn, xo + 64 * j);
                    else { v2u o; o.x = pk2(xn[0], xn[1]); o.y = pk2(xn[2], xn[3]); xr[64 * j] = o;
                           f32x4 xq; xq[0] = bflo(o.x); xq[1] = bfhi(o.x); xq[2] = bflo(o.y); xq[3] = bfhi(o.y); ss += sq4v(xq); } }
                if (!last) { ss = wave_sum(ss); if (lane == 0) rsout[row] = 1.0f / sqrtf(ss * (1.0f / DM_) + EPS); }
            } }
    }
}

__device__ __forceinline__ void qk_prep(const Frame& F) {
    unsigned char* ws_ = karg_ws();
    bf16* q = (bf16*)(ws_ + WS_Q); bf16* k = (bf16*)(ws_ + WS_K); const f32x2* rope = (const f32x2*)(ws_ + WS_ROPE); const float *qn = IN(21), *kn = IN(22);
    const int gt = F.vcu * NTHR + F.tid, sub = gt & 7; const int ngrp = F.G * NTHR / 8;
    for (int g0 = gt >> 3; g0 < M * 10; g0 += 4 * ngrp) {
        v4u wv[4];
#pragma unroll
        for (int u = 0; u < 4; ++u) { const int g = (g0 + u * ngrp < M * 10) ? g0 + u * ngrp : g0; const int tok = g / 10, hh = g - tok * 10;
            const bf16* p = (hh < 8 ? q + (size_t)tok * 512 + hh * 64 : k + (size_t)tok * 128 + (hh - 8) * 64) + sub * 8; wv[u] = *(const v4u*)p; }
#pragma unroll
        for (int u = 0; u < 4; ++u) { const int g = g0 + u * ngrp;
            if (g < M * 10) {
                const int tok = g / 10, hh = g - tok * 10; bf16* p = (hh < 8 ? q + (size_t)tok * 512 + hh * 64 : k + (size_t)tok * 128 + (hh - 8) * 64) + sub * 8;
                const v4u w = wv[u]; float x[8] = {bflo(w.x), bfhi(w.x), bflo(w.y), bfhi(w.y), bflo(w.z), bfhi(w.z), bflo(w.w), bfhi(w.w)};
                float ss = 0.f;
#pragma unroll
                for (int e = 0; e < 8; ++e) ss += x[e] * x[e];
                ss += __shfl_xor(ss, 1); ss += __shfl_xor(ss, 2); ss += __shfl_xor(ss, 4);
                const float r = 1.0f / sqrtf(ss * (1.0f / 64.0f) + EPS); const float* gn = (hh < 8 ? qn : kn) + sub * 8; const float sc = (hh < 8) ? QSCALE : 1.0f;
                const f32x2* rp = rope + (size_t)(tok & (SEQ - 1)) * 32 + sub * 4; float y[8];
#pragma unroll
                for (int e = 0; e < 4; ++e) { const float y0 = x[2 * e] * r * gn[2 * e], y1 = x[2 * e + 1] * r * gn[2 * e + 1]; const f32x2 cs = rp[e];
                    y[2 * e] = (y0 * cs.x - y1 * cs.y) * sc; y[2 * e + 1] = (y0 * cs.y + y1 * cs.x) * sc; }
                v4u o; o.x = pk2(y[0], y[1]); o.y = pk2(y[2], y[3]); o.z = pk2(y[4], y[5]); o.w = pk2(y[6], y[7]); *(v4u*)p = o;
            } }
    }
}

__device__ __forceinline__ void hyena_phase(const Frame& F) {
    unsigned char* ws_ = karg_ws();
    const bf16* hyT = (const bf16*)(ws_ + WS_HYT); const bf16* filt = (const bf16*)(ws_ + WS_FILT); bf16* yaT = (bf16*)(ws_ + WS_HB);
    const float *sw = IN(10), *sb = IN(11), *hbias = IN(20);
    LAS bf16* Z = (LAS bf16*)F.lds + ZO; LAS bf16* FL = (LAS bf16*)(F.lds + HY_F_OFF);
    const int tid = F.tid, lane = F.lane, w = F.wave, fr = lane & 15, fq = lane >> 4;
    for (int e = F.tid; e < 16 * 48; e += NTHR) { const int b = e / 48, j = e % 48; const int col = j < 24 ? -192 + 8 * j : 4096 + 8 * (j - 24); *(LAS v4u*)(Z + b * ZS + col) = (v4u){0u, 0u, 0u, 0u}; }
    __syncthreads();
    for (int c = F.vcu; c < HYW; c += F.G) {
        { const bf16* src = hyT + (size_t)c * M; const float w0 = sw[c], w1 = sw[3 * HYW + c], w2 = sw[6 * HYW + c], bb = sb[c];
          int tz = tid; asm volatile("" : "+v"(tz));
#pragma unroll 4
          for (int i = 0; i < 16; ++i) { const int qd = tz + NTHR * i, b = qd >> 9, t0 = (qd & 511) * 8; const bf16* p = src + b * SEQ + t0; const v4u v = *(const v4u*)p;
              float x[10]; { const float xm = bf1(p[-1]), xp = bf1(p[8]); x[0] = t0 > 0 ? xm : 0.f; x[9] = (t0 + 8 < SEQ) ? xp : 0.f; }
              x[1] = bflo(v.x); x[2] = bfhi(v.x); x[3] = bflo(v.y); x[4] = bfhi(v.y); x[5] = bflo(v.z); x[6] = bfhi(v.z); x[7] = bflo(v.w); x[8] = bfhi(v.w);
              float y[8];
#pragma unroll
              for (int e = 0; e < 8; ++e) y[e] = w0 * x[e] + w1 * x[e + 1] + w2 * x[e + 2] + bb;
              v4u o; o.x = pk2(y[0], y[1]); o.y = pk2(y[2], y[3]); o.z = pk2(y[4], y[5]); o.w = pk2(y[6], y[7]); *(LAS v4u*)(Z + b * ZS + t0) = o; } }
        for (int o = 0; o < 2; ++o) {
            { int tf = tid; asm volatile("" : "+v"(tf)); const v4u* fs = (const v4u*)(filt + (size_t)(o * HYW + c) * 8192); ((LAS v4u*)FL)[tf] = fs[tf]; ((LAS v4u*)FL)[tf + NTHR] = fs[tf + NTHR]; }
            __syncthreads();
            f32x4 acc[8][4];
#pragma unroll
            for (int i = 0; i < 8; ++i)
#pragma unroll
                for (int mt = 0; mt < 4; ++mt) acc[i][mt] = (f32x4){0.f, 0.f, 0.f, 0.f};
            const LAS unsigned* FLd = (const LAS unsigned*)FL; const int qbase = 4127 - fr + 8 * fq; const unsigned fsh = (qbase & 1) ? 16u : 0u;
            const LAS bf16* zrow = Z + fr * ZS + 8 * fq;
            bf16x8 af[6];
#define HYC_PIN2(a, b) asm volatile("" : "+v"(wr[a][0]), "+v"(wr[a][1]), "+v"(wr[a][2]), "+v"(wr[a][3]), "+v"(wr[a][4]), "+v"(wr[b][0]), "+v"(wr[b][1]), "+v"(wr[b][2]), "+v"(wr[b][3]), "+v"(wr[b][4]))
#define HYC_FRAG(dd) do { unsigned wr[6][5]; \
                _Pragma("unroll") for (int k = 0; k < 6; ++k) { const LAS unsigned* wp = FLd + ((qbase - 64 * (dd) - 16 * k) >> 1); \
                    _Pragma("unroll") for (int i5 = 0; i5 < 5; ++i5) wr[k][i5] = wp[i5]; } \
                HYC_PIN2(0, 1); HYC_PIN2(2, 3); HYC_PIN2(4, 5); \
                _Pragma("unroll") for (int k = 0; k < 6; ++k) { v4u fv; fv.x = __builtin_amdgcn_alignbit(wr[k][1], wr[k][0], fsh); fv.y = __builtin_amdgcn_alignbit(wr[k][2], wr[k][1], fsh); \
                    fv.z = __builtin_amdgcn_alignbit(wr[k][3], wr[k][2], fsh); fv.w = __builtin_amdgcn_alignbit(wr[k][4], wr[k][3], fsh); af[k] = __builtin_bit_cast(bf16x8, fv); } } while (0)
#define HYC_TB(j) (8 * w + (j))
#define HYC_ZLD2(buf, jp, dpv) do { _Pragma("unroll") for (int t2 = 0; t2 < 2; ++t2) { const int sb_ = (HYC_TB(2 * (jp) + t2) - (dpv)) & 63; const volatile LAS v4u* zp_ = (const volatile LAS v4u*)(zrow + 64 * sb_); \
                    zP[buf][t2][0] = zp_[0]; zP[buf][t2][1] = zp_[4]; } } while (0)
            v4u zP[2][2][2];
            HYC_ZLD2(0, 0, 0);
            for (int dp = 0; dp < 64; ++dp) {
                const int n_ = dp - 8 * w; const int nN = n_ < 0 ? 0 : (n_ > 8 ? 8 : n_);
                { const int d0 = nN > 0 ? dp - 64 : dp; HYC_FRAG(d0); }
#pragma unroll
                for (int jp = 0; jp < 4; ++jp) {
                    if (jp < 3) HYC_ZLD2((jp + 1) & 1, jp + 1, dp); else HYC_ZLD2(0, 0, dp + 1);
#pragma unroll
                    for (int t2 = 0; t2 < 2; ++t2) { const int j = 2 * jp + t2;
                        if (j > 0 && j == nN) HYC_FRAG(dp);
                        const bf16x8 z0 = __builtin_bit_cast(bf16x8, zP[jp & 1][t2][0]), z1 = __builtin_bit_cast(bf16x8, zP[jp & 1][t2][1]);
#pragma unroll
                        for (int mt = 0; mt < 4; ++mt) acc[j][mt] = __builtin_amdgcn_mfma_f32_16x16x32_bf16(af[mt + 2], z0, acc[j][mt], 0, 0, 0);
#pragma unroll
                        for (int mt = 0; mt < 4; ++mt) acc[j][mt] = __builtin_amdgcn_mfma_f32_16x16x32_bf16(af[mt], z1, acc[j][mt], 0, 0, 0); }
                }
            }
#undef HYC_PIN2
#undef HYC_FRAG
#undef HYC_TB
#undef HYC_ZLD2
            int el_ = tid; asm volatile("" : "+v"(el_)); const int efr = el_ & 15, efq = (el_ >> 4) & 3;
            const int gch = (o + 1) * HYW + c; const bf16* gsrc = hyT + (size_t)gch * M + efr * SEQ; const float w0 = sw[gch], w1 = sw[3 * HYW + gch], w2 = sw[6 * HYW + gch], bb = sb[gch], hbv = hbias[o * HYW + c];
#pragma unroll
            for (int i = 0; i < 8; ++i) { int t0i = 64 * (8 * w + i) + 4 * efq; asm volatile("" : "+v"(t0i));
#pragma unroll
                for (int mt = 0; mt < 4; ++mt) { const int t0 = t0i + 16 * mt; const bf16* p = gsrc + t0; const v2u gv = *(const v2u*)p;
                    float x[6]; { const float xm = bf1(p[-1]), xp = bf1(p[4]); x[0] = (t0 & (SEQ - 1)) != 0 ? xm : 0.f; x[5] = ((t0 + 4) & (SEQ - 1)) != 0 ? xp : 0.f; } x[1] = bflo(gv.x); x[2] = bfhi(gv.x); x[3] = bflo(gv.y); x[4] = bfhi(gv.y);
                    const v2u zv = *(const LAS v2u*)(Z + efr * ZS + t0); const float zz[4] = {bflo(zv.x), bfhi(zv.x), bflo(zv.y), bfhi(zv.y)};
#pragma unroll
                    for (int j = 0; j < 4; ++j) { const float gte = w0 * x[j] + w1 * x[j + 1] + w2 * x[j + 2] + bb; acc[i][mt][j] = gte * (acc[i][mt][j] + zz[j] * hbv); }
                    asm volatile("" ::: "memory"); } }
            __syncthreads();
            if (o == 0) {
#pragma unroll
                for (int i = 0; i < 8; ++i) { int t0i = 64 * (8 * w + i) + 4 * efq; asm volatile("" : "+v"(t0i));
#pragma unroll
                    for (int mt = 0; mt < 4; ++mt) { const int t0 = t0i + 16 * mt; v2u ov; ov.x = pk2(acc[i][mt][0], acc[i][mt][1]); ov.y = pk2(acc[i][mt][2], acc[i][mt][3]); *(LAS v2u*)(Z + efr * ZS + t0) = ov; } }
            } else {
#pragma unroll
                for (int i = 0; i < 8; ++i) { int t0i = 64 * (8 * w + i) + 4 * efq; asm volatile("" : "+v"(t0i));
#pragma unroll
                    for (int mt = 0; mt < 4; ++mt) { const int t0 = t0i + 16 * mt; v2u ov; ov.x = pk2(acc[i][mt][0], acc[i][mt][1]); ov.y = pk2(acc[i][mt][2], acc[i][mt][3]);
                        *(v2u*)(yaT + (size_t)c * M + (size_t)efr * SEQ + t0) = ov; }
                    asm volatile("" ::: "memory"); }
            }
        }
        __syncthreads();
    }
}
__device__ __forceinline__ void ya_transpose(const Frame& F) {
    unsigned char* ws_ = karg_ws(); const bf16* yT = (const bf16*)(ws_ + WS_HB); bf16* ya = (bf16*)(ws_ + WS_YA);
    LAS bf16* sT = (LAS bf16*)F.lds;
    const int ch = F.tid & 7, r = F.tid >> 3;
    v4u v[4];
    { const int gi = F.vcu < 8 * 256 ? F.vcu : 0; const int c0 = 64 * (gi & 7), t0 = 256 * (gi >> 3);
#pragma unroll
      for (int k = 0; k < 4; ++k) v[k] = *(const v4u*)(yT + (size_t)(c0 + r) * M + t0 + 64 * k + 8 * ch); }
    for (int gi = F.vcu; gi < 8 * 256; gi += F.G) {
        const int c0 = 64 * (gi & 7), t0 = 256 * (gi >> 3);
        v4u vn[4];
        { const int gn = gi + F.G < 8 * 256 ? gi + F.G : gi; const int cn = 64 * (gn & 7), tn = 256 * (gn >> 3);
#pragma unroll
          for (int k = 0; k < 4; ++k) vn[k] = *(const v4u*)(yT + (size_t)(cn + r) * M + tn + 64 * k + 8 * ch); }
#pragma unroll
        for (int k = 0; k < 4; ++k) { LAS bf16* d = sT + k * (64 * 66) + (8 * ch) * 66 + r; const unsigned w[4] = {v[k].x, v[k].y, v[k].z, v[k].w};
#pragma unroll
            for (int j = 0; j < 4; ++j) { d[(2 * j) * 66] = (bf16)(w[j] & 0xffffu); d[(2 * j + 1) * 66] = (bf16)(w[j] >> 16); } }
        __syncthreads();
#pragma unroll
        for (int k = 0; k < 4; ++k) { const LAS unsigned* sp = (const LAS unsigned*)(sT + k * (64 * 66) + r * 66 + 8 * ch); v4u o; o.x = sp[0]; o.y = sp[1]; o.z = sp[2]; o.w = sp[3];
            *(v4u*)(ya + (size_t)(t0 + 64 * k + r) * HYW + c0 + 8 * ch) = o; }
        __syncthreads();
#pragma unroll
        for (int k = 0; k < 4; ++k) v[k] = vn[k];
    }
}

constexpr int N_STEPS = 15;
#ifndef ONE_LAUNCH
#define ONE_LAUNCH 1
#endif
#ifndef STEP_MASK
#define STEP_MASK 0xFFFF
#endif
__device__ __forceinline__ bool gemm_desc(int st, int q, unsigned char* ws, pg8::Gemm& g, pg8::EpiGen& e) {
    bf16* XB = (bf16*)(ws + WS_XB); bf16* HB = (bf16*)(ws + WS_HB);
    e.ws = ws; e.aux = nullptr; e.O = HB; e.ldc = DM_; e.midk = 0;
    if (q == 0) {
        switch (st) {
        case 1: case 10: g = pg8::Gemm{XB, (const bf16*)(ws + (st == 10 ? WS_GU2 : WS_GU1)), M, 2 * FF, DM_}; e.mode = pg8::EM_SWIGLU; e.O = (bf16*)(ws + WS_ACT); e.ldc = FF; return true;
        case 2: case 11: g = pg8::Gemm{(const bf16*)(ws + WS_ACT), (const bf16*)(ws + (st == 11 ? WS_D2 : WS_D1)), M, DM_, FF}; e.mode = pg8::EM_HSUM; return true;
        case 4: g = pg8::Gemm{(const bf16*)(ws + WS_IN), XB, 3 * HYW, M, DM_}; e.mode = pg8::EM_HYT; e.O = (bf16*)(ws + WS_HYT); e.ldc = M; return true;
        case 7: g = pg8::Gemm{(const bf16*)(ws + WS_YA), (const bf16*)(ws + WS_HYO), M, DM_, HYW, (const bf16*)(ws + WS_YB), (const bf16*)(ws + WS_ATO)}; e.mode = pg8::EM_MERGEA; e.O = (bf16*)(ws + WS_MRG); e.aux = (const bf16*)(ws + WS_SGB); e.midk = 1; return true;
        case 8: g = pg8::Gemm{(const bf16*)(ws + WS_MRG), (const bf16*)(ws + WS_OUT), M, DM_, DM_}; e.mode = pg8::EM_HSUM; return true;
        case 13: g = pg8::Gemm{(const bf16*)(ws + WS_PB), (const bf16*)(ws + WS_PP), M, DM_, PLE}; e.mode = pg8::EM_PLAIN; e.O = (bf16*)(ws + WS_PBUF); return true;
        default: return false;
        }
    } else {
        switch (st) {
        case 4: g = pg8::Gemm{XB, (const bf16*)(ws + WS_IN) + (size_t)3 * HYW * DM_, M, INC - 3 * HYW, DM_}; e.mode = pg8::EM_QKVG; return true;
        case 13: g = pg8::Gemm{XB, (const bf16*)(ws + WS_PG), M, DM_, DM_}; e.mode = pg8::EM_PLEG; e.aux = (const bf16*)(ws + WS_PBUF); return true;
        default: return false;
        }
    }
}
__global__ void __launch_bounds__(NTHR, 2) fwd_kernel(Args args) {
    extern __shared__ __attribute__((aligned(16))) unsigned char lds[];
    const int step_lo = args.step_lo, step_hi = args.step_hi;
    if (threadIdx.x < 2) ((volatile LAS unsigned*)((LAS unsigned char*)lds + BARST_OFF))[threadIdx.x] = 0u;
    __syncthreads();
    const XcdBarrier bar = xcd_barrier_post((unsigned*)karg_ws(), (volatile LAS unsigned*)((LAS unsigned char*)lds + BARST_OFF));
    for (int st = step_lo; st < step_hi; ++st) {
        if (st > step_lo) { if (step_hi > 1000) cg::this_grid().sync(); xcd_barrier(bar); }
        if (!((STEP_MASK >> st) & 1)) continue;
        unsigned char* ws = karg_ws();
        int tid_ = threadIdx.x; asm volatile("" : "+v"(tid_));
        Frame F; F.lds = (LAS unsigned char*)lds; F.tid = tid_; F.lane = F.tid & 63; F.wave = __builtin_amdgcn_readfirstlane(F.tid >> 6);
        F.G = gridDim.x; { const int bx = blockIdx.x; F.vcu = (F.G % 8 == 0) ? (bx % 8) * (F.G / 8) + bx / 8 : bx; }
        bf16* XB = (bf16*)(ws + WS_XB); bf16* HB = (bf16*)(ws + WS_HB); float* RS = (float*)(ws + WS_RS); float* PART = (float*)(ws + WS_PART);
        switch (st) {
        case 0: if constexpr (STEP_MASK & 1) prologue(F); break;
        case 1: if constexpr ((STEP_MASK >> 1) & 1) filter_cols(F); break;
        case 5: if constexpr ((STEP_MASK >> 5) & 1) { qk_prep(F); hyena_phase(F); } break;
        case 6: if constexpr ((STEP_MASK >> 6) & 1) { ya_transpose(F); const attn_body::AttnTensors AT{(const attn_body::bf16*)(ws + WS_Q), (const attn_body::bf16*)(ws + WS_K), (const attn_body::bf16*)(ws + WS_V), (attn_body::bf16*)(ws + WS_YB)};
            const attn_body::StaticOrder S((int)F.G, (int)blockIdx.x); attn_body::attn_phase<attn_body::StaticOrder>((char*)lds, AT, S); } break;
        case 12: if constexpr ((STEP_MASK >> 12) & 1) {
            { const f32x4* p4 = (const f32x4*)IN(1); v2u* pb = (v2u*)(ws + WS_PB);
              for (int i = F.vcu * NTHR + F.tid; i < M * PLE / 4; i += F.G * NTHR) { const f32x4 v = p4[i]; v2u o; o.x = pk2(v[0], v[1]); o.y = pk2(v[2], v[3]); pb[i] = o; } } } break;
        default: break;
        }
        if (st == 3 || st == 9 || st == 12 || st == 14) {
            const float* gp = IN(st == 3 ? 3 : st == 9 ? 8 : st == 12 ? 27 : 32);
            elem_pass(F, XB, HB, PART, gp, (st == 3 || st == 12) ? 0.5f : 1.0f, karg_out(), RS, st == 14);
        }
#ifndef NO_GEMM
        for (int q = 0; q < 2; ++q) {
            pg8::Gemm g; pg8::EpiGen e;
            if (!gemm_desc(st, q, ws, g, e)) break;
            pg8::StaticOrder S; S.init(g.M, g.N, F.G, (int)blockIdx.x); S.dual = e.midk;
            pg8::gemm_phase<pg8::EpiGen, pg8::StaticOrder, true, true>(F.lds, g, S, e);
            __syncthreads();
        }
#endif
    }
}

extern "C" void kernel_launch(void* const* d_in, const int* in_sizes, int n_in, void* d_out, int out_size, void* d_ws, size_t ws_size, hipStream_t stream) {
    static int grid = 0;
    if (grid == 0) {
        if (n_in != 35 || ws_size < WS_END) { fprintf(stderr, "kernel_launch: unexpected n_in %d / ws %zu\n", n_in, ws_size); grid = -1; return; }
        int dev = 0, cus = 0, per_cu = 0;
        (void)hipGetDevice(&dev); (void)hipDeviceGetAttribute(&cus, hipDeviceAttributeMultiprocessorCount, dev);
        if (hipFuncSetAttribute((const void*)fwd_kernel, hipFuncAttributeMaxDynamicSharedMemorySize, LDS_BYTES) != hipSuccess) { fprintf(stderr, "kernel_launch: hipFuncSetAttribute failed\n"); grid = -1; return; }
        if (hipOccupancyMaxActiveBlocksPerMultiprocessor(&per_cu, (const void*)fwd_kernel, NTHR, LDS_BYTES) != hipSuccess || per_cu < 1) { fprintf(stderr, "kernel_launch: occupancy query says %d\n", per_cu); per_cu = 1; }
        (void)hipGetLastError();
        grid = cus > 0 ? cus : 256;
    }
    if (grid < 0) return;
    if (hipMemsetAsync(d_ws, 0, CTL_ZERO_BYTES, stream) != hipSuccess) { fprintf(stderr, "kernel_launch: memset of the barrier words failed\n"); return; }
    Args a{};
    for (int i = 0; i < 35; ++i) a.in[i] = (const float*)d_in[i];
    a.out = (float*)d_out; a.ws = (unsigned char*)d_ws;
#if ONE_LAUNCH
    a.step_lo = 0; a.step_hi = N_STEPS;
    void* kargs[] = {&a};
    hipError_t e = hipLaunchCooperativeKernel((const void*)fwd_kernel, dim3(grid), dim3(NTHR), kargs, LDS_BYTES, stream);
    if (e != hipSuccess) fprintf(stderr, "cooperative launch failed: %s (grid %d)\n", hipGetErrorString(e), grid);
#else
    for (int st = 0; st < N_STEPS; ++st) { a.step_lo = st; a.step_hi = st + 1; hipLaunchKernelGGL(fwd_kernel, dim3(grid), dim3(NTHR), LDS_BYTES, stream, a); }
#endif
}
```

```cpp
#include <hip/hip_runtime.h>
#include <hip/hip_cooperative_groups.h>
#include <hip/hip_bf16.h>
#include <cstdio>
#include <cstdint>
#include <cmath>
namespace cg = cooperative_groups;
constexpr int DM_ = 1024, BATCH = 16, SEQ = 4096, M = BATCH * SEQ, FF = 2816, HYW = 512, PLE = 256, INC = 4352;
constexpr float EPS = 1e-6f;
constexpr float QSCALE = 0.125f * 1.4426950408889634f;
constexpr size_t MiB = 1u << 20;
constexpr size_t WS_GU1 = 1 * MiB, WS_D1 = 12 * MiB, WS_IN = 18 * MiB, WS_HYO = 27 * MiB, WS_ATO = 28 * MiB, WS_OUT = 29 * MiB, WS_GU2 = 31 * MiB, WS_D2 = 42 * MiB, WS_PG = 48 * MiB, WS_PP = 50 * MiB;
constexpr size_t WS_FILT = 52 * MiB, WS_H2 = 68 * MiB, WS_ROPE = 69 * MiB, WS_RS = 70 * MiB, WS_PART = 71 * MiB;
constexpr size_t WS_XB = 76 * MiB, WS_HB = 204 * MiB, WS_BIG = 332 * MiB;
constexpr size_t WS_ACT = WS_BIG, WS_HYT = WS_BIG, WS_SGA = 524 * MiB, WS_SGB = 652 * MiB, WS_Q = 780 * MiB, WS_K = 844 * MiB, WS_V = 860 * MiB, WS_YA = 876 * MiB, WS_MRG = WS_BIG;
constexpr size_t WS_PB = WS_BIG, WS_PBUF = 364 * MiB, WS_YB = 940 * MiB, WS_END = 1004 * MiB;
namespace pg8 {
#define PG8_LAS __attribute__((address_space(3)))
typedef unsigned short bf16_t;
typedef short bf16x8 __attribute__((ext_vector_type(8)));
typedef float f32x4 __attribute__((ext_vector_type(4)));
typedef unsigned u32x4 __attribute__((ext_vector_type(4)));
constexpr int BM = 256, BK = 64, HALF = 128, HTB = HALF * BK * 2  , STAGE_BYTES = 8 * HTB, NXCD = 8, WGM = 4;

__host__ __device__ __forceinline__ int lds_byte(int r, int c) { const int st = (r >> 4) * 2 + (c >> 5), rr = r & 15, cc = c & 31, ob = rr * 64 + cc * 2; return st * 1024 + (ob ^ (((ob >> 9) & 1) << 5)); }
__host__ __device__ __forceinline__ void stage_rc(int b, int& R, int& C) { const int st = b / 1024, sb = b % 1024, swz = sb ^ (((sb >> 9) & 1) << 5); R = (st >> 1) * 16 + swz / 64; C = (st & 1) * 32 + (swz % 64) / 2; }
__host__ __device__ __forceinline__ int perm32(int rho) { const int n = rho >> 4, i = rho & 15; return 8 * (i >> 2) + 4 * n + (i & 3); }

struct Unit { int pm, pn, half; };
struct Gemm { const bf16_t* A; const bf16_t* Bt; int M, N, K; const bf16_t* A2; const bf16_t* Bt2; };

struct StaticOrder {
    int nM, nN, nwg, G, c, dual, wgm;
    __host__ __device__ void init(int M, int N, int G_, int c_) { nM = M / BM; nN = N / BM; nwg = nM * nN; G = G_; c = c_; dual = 0; wgm = WGM; }
    __host__ __device__ bool next(int i, Unit& u) const {
        const int ii = dual ? (i >> 1) : i; u.half = dual ? (i & 1) : 0;
        const long L = (long)ii * G + c; if (L >= nwg) return false;
        int wgid = (int)L; { const int q = nwg / NXCD, r = nwg % NXCD, xcd = wgid % NXCD, off = wgid / NXCD; wgid = (xcd < r ? xcd * (q + 1) : r * (q + 1) + (xcd - r) * q) + off; }
        const int nig = wgm * nN, gid = wgid / nig, fm = gid * wgm, gsz = (nM - fm) < wgm ? (nM - fm) : wgm;
        u.pm = fm + ((wgid % nig) % gsz); u.pn = (wgid % nig) / gsz; return true;
    }
    __device__ __forceinline__ void a_ready(const Unit&) const {}
    __device__ __forceinline__ void done(const Unit&) const {}
};

__device__ __forceinline__ unsigned cvt_pk_bf16(float lo, float hi) { unsigned r; asm volatile("v_cvt_pk_bf16_f32 %0, %1, %2" : "=v"(r) : "v"(lo), "v"(hi)); return r; }
typedef float f32x2 __attribute__((ext_vector_type(2)));
enum { EM_SWIGLU = 0, EM_HSUM = 1, EM_HYT = 2, EM_QKVG = 3, EM_MERGEA = 4, EM_MERGEB = 5, EM_PLAIN = 6, EM_PLEG = 7 };
__device__ __forceinline__ void st8(bf16_t* p, f32x4 v0, f32x4 v1) { u32x4 w; w.x = cvt_pk_bf16(v0[0], v0[1]); w.y = cvt_pk_bf16(v0[2], v0[3]); w.z = cvt_pk_bf16(v1[0], v1[1]); w.w = cvt_pk_bf16(v1[2], v1[3]); *(u32x4*)p = w; }
__device__ __forceinline__ void ld8(const bf16_t* p, f32x4& v0, f32x4& v1) { const u32x4 w = *(const u32x4*)p;
    v0[0] = __uint_as_float(w.x << 16); v0[1] = __uint_as_float(w.x & 0xffff0000u); v0[2] = __uint_as_float(w.y << 16); v0[3] = __uint_as_float(w.y & 0xffff0000u);
    v1[0] = __uint_as_float(w.z << 16); v1[1] = __uint_as_float(w.z & 0xffff0000u); v1[2] = __uint_as_float(w.w << 16); v1[3] = __uint_as_float(w.w & 0xffff0000u); }
__device__ __forceinline__ void un8(const u32x4 w, f32x4& v0, f32x4& v1) {
    v0[0] = __uint_as_float(w.x << 16); v0[1] = __uint_as_float(w.x & 0xffff0000u); v0[2] = __uint_as_float(w.y << 16); v0[3] = __uint_as_float(w.y & 0xffff0000u);
    v1[0] = __uint_as_float(w.z << 16); v1[1] = __uint_as_float(w.z & 0xffff0000u); v1[2] = __uint_as_float(w.w << 16); v1[3] = __uint_as_float(w.w & 0xffff0000u); }
__device__ __forceinline__ float sigm(float x) { return __builtin_amdgcn_rcpf(1.0f + __builtin_amdgcn_exp2f(-1.4426950408889634f * x)); }
__device__ __forceinline__ f32x4 sigm4(f32x4 v) { f32x4 o; o[0] = sigm(v[0]); o[1] = sigm(v[1]); o[2] = sigm(v[2]); o[3] = sigm(v[3]); return o; }
__device__ __forceinline__ float sq4(f32x4 v) { return (v[0] * v[0] + v[1] * v[1]) + (v[2] * v[2] + v[3] * v[3]); }
struct EpiGen {
    static constexpr bool PERM = true, AFTER_DRAIN = false;
    int mode; int ldc; int midk;
    bf16_t* O;
    const bf16_t* aux;
    unsigned char* ws;
    __device__ __forceinline__ void mid(f32x4 (&acc)[2][2][4][2], const Unit& u, int wr, int wc, int fr, int fq) const {
        const int row0 = u.pm * BM + wr * 64 + fr, cw = wc * 32 + 8 * fq;
        const bf16_t* sga = (const bf16_t*)(ws + WS_SGA); const bf16_t* sgb = (const bf16_t*)(ws + WS_SGB);
#pragma unroll
        for (int ai = 0; ai < 2; ++ai)
#pragma unroll
        for (int mh = 0; mh < 2; ++mh) {
            u32x4 ga[2][2], gb[2][2];
#pragma unroll
            for (int ml = 0; ml < 2; ++ml)
#pragma unroll
                for (int bj = 0; bj < 2; ++bj) { const size_t off = (size_t)(row0 + ai * HALF + (2 * mh + ml) * 16) * DM_ + u.pn * BM + bj * HALF + cw; ga[ml][bj] = *(const u32x4*)(sga + off); gb[ml][bj] = *(const u32x4*)(sgb + off); }
#pragma unroll
            for (int ml = 0; ml < 2; ++ml)
#pragma unroll
                for (int bj = 0; bj < 2; ++bj) { f32x4 a0, a1, b0, b1; un8(ga[ml][bj], a0, a1); un8(gb[ml][bj], b0, b1); const int m = 2 * mh + ml;
#pragma unroll
                    for (int j = 0; j < 4; ++j) { acc[ai][bj][m][0][j] *= a0[j] * __builtin_amdgcn_rcpf(b0[j]); acc[ai][bj][m][1][j] *= a1[j] * __builtin_amdgcn_rcpf(b1[j]); } }
            asm volatile("" ::: "memory");
        }
    }
    __device__ __forceinline__ void operator()(const f32x4 (&acc)[2][2][4][2], const Unit& u, int wr, int wc, int fr, int fq) const {
        const int row0 = u.pm * BM + wr * 64 + fr, cw = wc * 32 + 8 * fq;
        const float* rs = (const float*)(ws + WS_RS); float* part = (float*)(ws + WS_PART);
        bf16_t *oq = (bf16_t*)(ws + WS_Q), *ok = (bf16_t*)(ws + WS_K), *ov = (bf16_t*)(ws + WS_V), *oga = (bf16_t*)(ws + WS_SGA), *ogb = (bf16_t*)(ws + WS_SGB);
        if (mode == EM_SWIGLU) {
            float r8[2][4];
#pragma unroll
            for (int ai = 0; ai < 2; ++ai)
#pragma unroll
                for (int m = 0; m < 4; ++m) r8[ai][m] = rs[row0 + ai * HALF + m * 16];
#pragma unroll
            for (int ai = 0; ai < 2; ++ai)
#pragma unroll
                for (int m = 0; m < 4; ++m) { const int row = row0 + ai * HALF + m * 16; const float r = r8[ai][m]; f32x4 o[2];
#pragma unroll
                    for (int n = 0; n < 2; ++n) { const f32x4 g = acc[ai][0][m][n] * r, up = acc[ai][1][m][n] * r; o[n] = g * sigm4(g) * up; }
                    st8(O + (size_t)row * FF + u.pn * HALF + cw, o[0], o[1]); }
        } else if (mode == EM_HSUM) {
#pragma unroll
            for (int ai = 0; ai < 2; ++ai)
#pragma unroll
                for (int m = 0; m < 4; ++m) { const int row = row0 + ai * HALF + m * 16; float ss = 0.f;
#pragma unroll
                    for (int bj = 0; bj < 2; ++bj) { const size_t off = (size_t)row * DM_ + u.pn * BM + bj * HALF + cw; const f32x4 v0 = acc[ai][bj][m][0], v1 = acc[ai][bj][m][1];
                        ss += sq4(v0) + sq4(v1); st8(O + off, v0, v1); }
                    ss += __shfl_xor(ss, 16); ss += __shfl_xor(ss, 32);
                    if (fq == 0) part[(size_t)row * 16 + u.pn * 4 + wc] = ss; }
        } else if (mode == EM_HYT) {
            f32x4 rc[2][2];
#pragma unroll
            for (int bj = 0; bj < 2; ++bj) { const int col = u.pn * BM + bj * HALF + cw; rc[bj][0] = *(const f32x4*)(rs + col); rc[bj][1] = *(const f32x4*)(rs + col + 4); }
#pragma unroll
            for (int bj = 0; bj < 2; ++bj) { const int col = u.pn * BM + bj * HALF + cw;
#pragma unroll
                for (int ai = 0; ai < 2; ++ai)
#pragma unroll
                    for (int m = 0; m < 4; ++m) { const int row = row0 + ai * HALF + m * 16; st8(O + (size_t)row * M + col, acc[ai][bj][m][0] * rc[bj][0], acc[ai][bj][m][1] * rc[bj][1]); } }
        } else if (mode == EM_QKVG) {
            const int pn = u.pn;
            float r8[2][4];
#pragma unroll
            for (int ai = 0; ai < 2; ++ai)
#pragma unroll
                for (int m = 0; m < 4; ++m) r8[ai][m] = rs[row0 + ai * HALF + m * 16];
#pragma unroll
            for (int ai = 0; ai < 2; ++ai)
#pragma unroll
                for (int m = 0; m < 4; ++m) { const int row = row0 + ai * HALF + m * 16; const float r = r8[ai][m];
#pragma unroll
                    for (int bj = 0; bj < 2; ++bj) { f32x4 v0 = acc[ai][bj][m][0] * r, v1 = acc[ai][bj][m][1] * r; const int ct = bj * HALF + cw;
                        if (pn < 2) st8(oq + (size_t)row * 512 + pn * BM + ct, v0, v1);
                        else if (pn == 2) st8((bj == 0 ? ok : ov) + (size_t)row * 128 + cw, v0, v1);
                        else if (pn < 7) st8(oga + (size_t)row * 1024 + (pn - 3) * BM + ct, sigm4(v0), sigm4(v1));
                        else st8(ogb + (size_t)row * 1024 + (pn - 7) * BM + ct, sigm4(v0), sigm4(v1)); } }
        } else {
#pragma unroll
            for (int ai = 0; ai < 2; ++ai)
#pragma unroll
            for (int mh = 0; mh < 2; ++mh) {
                u32x4 ga[2][2], pa[2][2]; float rg[2] = {1.f, 1.f};
                if (mode == EM_PLEG) { rg[0] = rs[row0 + ai * HALF + (2 * mh) * 16]; rg[1] = rs[row0 + ai * HALF + (2 * mh + 1) * 16]; }
                if (mode != EM_PLAIN) {
#pragma unroll
                    for (int ml = 0; ml < 2; ++ml)
#pragma unroll
                        for (int bj = 0; bj < 2; ++bj) { const size_t off = (size_t)(row0 + ai * HALF + (2 * mh + ml) * 16) * DM_ + u.pn * BM + bj * HALF + cw; ga[ml][bj] = *(const u32x4*)(aux + off);
                            if (mode == EM_MERGEB) pa[ml][bj] = *(const u32x4*)(O + off); }
                }
#pragma unroll
                for (int ml = 0; ml < 2; ++ml) { const int m = 2 * mh + ml; const int row = row0 + ai * HALF + m * 16; float ss = 0.f; const float r = rg[ml];
#pragma unroll
                    for (int bj = 0; bj < 2; ++bj) { const size_t off = (size_t)row * DM_ + u.pn * BM + bj * HALF + cw; f32x4 v0 = acc[ai][bj][m][0], v1 = acc[ai][bj][m][1];
                        if (mode != EM_PLAIN) { f32x4 g0, g1; un8(ga[ml][bj], g0, g1);
                            if (mode == EM_PLEG) { v0 = sigm4(v0 * r) * g0; v1 = sigm4(v1 * r) * g1; } else { v0 = v0 * g0; v1 = v1 * g1; } }
                        if (mode == EM_MERGEB) { f32x4 p0, p1; un8(pa[ml][bj], p0, p1); v0 = v0 + p0; v1 = v1 + p1; }
                        if (mode == EM_PLEG) ss += sq4(v0) + sq4(v1);
                        st8(O + off, v0, v1); }
                    if (mode == EM_PLEG) { ss += __shfl_xor(ss, 16); ss += __shfl_xor(ss, 32); if (fq == 0) part[(size_t)row * 16 + u.pn * 4 + wc] = ss; } }
                asm volatile("" ::: "memory");
            }
        }
    }
};
template <class Epi, class Sched, bool ALIGN_EPI = false, bool SP2 = false>
__device__ __forceinline__ void gemm_phase(PG8_LAS unsigned char* lds, const Gemm g, const Sched& S, const Epi& E) {
    int tid_o = threadIdx.x; asm volatile("" : "+v"(tid_o)); const int tid = tid_o, wid = __builtin_amdgcn_readfirstlane(tid >> 6), lane = tid & 63, wr = wid >> 2, wc = wid & 3, fr = lane & 15, fq = lane >> 4;
    const int K = g.K, nt = K / BK;
    unsigned voffA[2], voffB[2];
#pragma unroll
    for (int i = 0; i < 2; ++i) { int R, C; stage_rc(tid * 16 + i * 8192, R, C); const int Rb = Epi::PERM ? ((R & ~31) + perm32(R & 31)) : R;
        voffA[i] = (unsigned)(R * K + C) * 2u; voffB[i] = (unsigned)(Rb * K + C) * 2u; }
    const size_t kstep = (size_t)(BK * 2);
    const size_t hstep = (size_t)HALF * K * 2;
    const size_t tstep = 2 * hstep;
    const unsigned ldsw = (unsigned)wid * 1024u;
    const int aoff = lds_byte(wr * 64 + fr, fq * 8), boff = lds_byte(wc * 32 + fr, fq * 8);
#define PG8_SA(b, h) (((b) * 2 + (h)) * HTB)
#define PG8_SB(b, h) ((4 + (b) * 2 + (h)) * HTB)
#define PG8_STAGE(bufoff, gbase, voff) do { _Pragma("unroll") for (int _i = 0; _i < 2; ++_i) \
        __builtin_amdgcn_global_load_lds((const unsigned*)((const char*)(gbase) + (voff)[_i]), (PG8_LAS unsigned*)(lds + (bufoff) + ldsw + _i * 8192), 16, 0, 0); } while (0)
#define PG8_LDA(dst, b, h) do { _Pragma("unroll") for (int m = 0; m < 4; ++m) _Pragma("unroll") for (int k = 0; k < 2; ++k) dst[m][k] = *(const PG8_LAS bf16x8*)(lds + PG8_SA(b, h) + aoff + m * 2048 + k * 1024); } while (0)
#define PG8_LDB(dst, b, h) do { _Pragma("unroll") for (int n = 0; n < 2; ++n) _Pragma("unroll") for (int k = 0; k < 2; ++k) dst[n][k] = *(const PG8_LAS bf16x8*)(lds + PG8_SB(b, h) + boff + n * 2048 + k * 1024); } while (0)
#define PG8_MMA(ai, bj, At, Bt) do { __builtin_amdgcn_s_setprio(1); _Pragma("unroll") for (int m = 0; m < 4; ++m) _Pragma("unroll") for (int n = 0; n < 2; ++n) _Pragma("unroll") for (int k = 0; k < 2; ++k) \
        acc[ai][bj][m][n] = __builtin_amdgcn_mfma_f32_16x16x32_bf16(Bt[n][k], At[m][k], acc[ai][bj][m][n], 0, 0, 0); __builtin_amdgcn_s_setprio(0); } while (0)
#define PG8_WAIT_V(n) asm volatile("s_waitcnt vmcnt(" #n ")" ::: "memory")
#define PG8_WAIT_L(n) asm volatile("s_waitcnt lgkmcnt(" #n ")" ::: "memory")
#define PG8_BAR __builtin_amdgcn_s_barrier()
#define PG8_SCHED __builtin_amdgcn_sched_barrier(0)
    Unit cur, nxt; int ui = 0;
    if (!S.next(0, cur)) return;
    f32x4 acc[2][2][4][2];
#pragma unroll
    for (int a = 0; a < 2; ++a)
#pragma unroll
        for (int b = 0; b < 2; ++b)
#pragma unroll
            for (int m = 0; m < 4; ++m)
#pragma unroll
                for (int n = 0; n < 2; ++n) acc[a][b][m][n] = (f32x4){0.f, 0.f, 0.f, 0.f};
    bf16x8 At[4][2], B0[2][2], B1[2][2];
    const char* cA = (const char*)(cur.half ? g.A2 : g.A) + (size_t)cur.pm * tstep; const char* cB = (const char*)(cur.half ? g.Bt2 : g.Bt) + (size_t)cur.pn * tstep;
    S.a_ready(cur);
    if constexpr (SP2) {
        PG8_STAGE(PG8_SB(0, 0), cB, voffB); PG8_STAGE(PG8_SB(0, 1), cB + hstep, voffB); PG8_STAGE(PG8_SA(0, 0), cA, voffA); PG8_STAGE(PG8_SA(0, 1), cA + hstep, voffA);
        if (wr == 1) PG8_BAR;
        PG8_WAIT_V(2); PG8_BAR;
        PG8_STAGE(PG8_SB(1, 0), cB + kstep, voffB); PG8_STAGE(PG8_SA(1, 0), cA + kstep, voffA); PG8_STAGE(PG8_SB(1, 1), cB + hstep + kstep, voffB);
        PG8_WAIT_V(6); PG8_BAR;
    } else {
        PG8_STAGE(PG8_SB(0, 0), cB, voffB); PG8_STAGE(PG8_SA(0, 0), cA, voffA); PG8_STAGE(PG8_SB(0, 1), cB + hstep, voffB); PG8_STAGE(PG8_SA(0, 1), cA + hstep, voffA);
        if (wr == 1) PG8_BAR;
        PG8_WAIT_V(4); PG8_BAR;
        PG8_STAGE(PG8_SB(1, 0), cB + kstep, voffB); PG8_STAGE(PG8_SA(1, 0), cA + kstep, voffA); PG8_STAGE(PG8_SB(1, 1), cB + hstep + kstep, voffB);
        PG8_WAIT_V(6); PG8_BAR;
    }
    for (;;) {
        const bool has_next = S.next(ui + 1, nxt);
        const char* nA = has_next ? (const char*)(nxt.half ? g.A2 : g.A) + (size_t)nxt.pm * tstep : cA; const char* nB = has_next ? (const char*)(nxt.half ? g.Bt2 : g.Bt) + (size_t)nxt.pn * tstep : cB;
        for (int t = 0; t < nt; t += 2) {
            const bool last = (t == nt - 2);
            const char* a1 = cA + (size_t)(t + 1) * kstep;
            const char* a2 = last ? nA : cA + (size_t)(t + 2) * kstep; const char* b2 = last ? nB : cB + (size_t)(t + 2) * kstep;
            const char* a3 = a2 + kstep; const char* b3 = b2 + kstep;
            if (last && has_next) S.a_ready(nxt);
            if constexpr (SP2) {
            PG8_LDB(B0, 0, 0); PG8_LDB(B1, 0, 1); PG8_SCHED; PG8_LDA(At, 0, 0); PG8_STAGE(PG8_SA(1, 1), a1 + hstep, voffA);
            PG8_WAIT_V(8); PG8_WAIT_L(0); PG8_BAR; PG8_MMA(0, 0, At, B0); PG8_MMA(0, 1, At, B1); PG8_BAR; PG8_SCHED;
            PG8_LDA(At, 0, 1); PG8_STAGE(PG8_SB(0, 0), b2, voffB); PG8_STAGE(PG8_SB(0, 1), b2 + hstep, voffB); PG8_STAGE(PG8_SA(0, 0), a2, voffA);
            PG8_WAIT_V(8); PG8_WAIT_L(0); PG8_BAR; PG8_MMA(1, 0, At, B0); PG8_MMA(1, 1, At, B1); PG8_BAR; PG8_SCHED;
            PG8_LDB(B0, 1, 0); PG8_LDB(B1, 1, 1); PG8_SCHED; PG8_LDA(At, 1, 0); PG8_STAGE(PG8_SA(0, 1), a2 + hstep, voffA);
            PG8_WAIT_V(8); PG8_WAIT_L(0); PG8_BAR; PG8_MMA(0, 0, At, B0); PG8_MMA(0, 1, At, B1); PG8_BAR; PG8_SCHED;
            PG8_LDA(At, 1, 1); PG8_STAGE(PG8_SB(1, 0), b3, voffB); PG8_STAGE(PG8_SB(1, 1), b3 + hstep, voffB); PG8_STAGE(PG8_SA(1, 0), a3, voffA);
            PG8_WAIT_V(8); PG8_WAIT_L(0); PG8_BAR; PG8_MMA(1, 0, At, B0); PG8_MMA(1, 1, At, B1); PG8_BAR; PG8_SCHED;
            } else {
            PG8_LDB(B0, 0, 0); PG8_SCHED; PG8_LDA(At, 0, 0); PG8_STAGE(PG8_SA(1, 1), a1 + hstep, voffA);
            PG8_WAIT_L(8); PG8_BAR; PG8_WAIT_L(0); PG8_MMA(0, 0, At, B0); PG8_BAR; PG8_SCHED;
            PG8_LDB(B1, 0, 1); PG8_STAGE(PG8_SB(0, 0), b2, voffB);
            PG8_BAR; PG8_WAIT_L(0); PG8_MMA(0, 1, At, B1); PG8_BAR;
            PG8_LDA(At, 0, 1); PG8_STAGE(PG8_SA(0, 0), a2, voffA);
            PG8_BAR; PG8_WAIT_L(0); PG8_MMA(1, 0, At, B0); PG8_BAR; PG8_SCHED;
            PG8_STAGE(PG8_SB(0, 1), b2 + hstep, voffB);
            PG8_WAIT_V(6); PG8_BAR; PG8_MMA(1, 1, At, B1); PG8_BAR;
            PG8_LDB(B0, 1, 0); PG8_SCHED; PG8_LDA(At, 1, 0); PG8_STAGE(PG8_SA(0, 1), a2 + hstep, voffA);
            PG8_WAIT_L(8); PG8_BAR; PG8_WAIT_L(0); PG8_MMA(0, 0, At, B0); PG8_BAR; PG8_SCHED;
            PG8_LDB(B1, 1, 1); PG8_STAGE(PG8_SB(1, 0), b3, voffB);
            PG8_BAR; PG8_WAIT_L(0); PG8_MMA(0, 1, At, B1); PG8_BAR;
            PG8_LDA(At, 1, 1); PG8_STAGE(PG8_SA(1, 0), a3, voffA);
            PG8_BAR; PG8_WAIT_L(0); PG8_MMA(1, 0, At, B0); PG8_BAR; PG8_SCHED;
            PG8_STAGE(PG8_SB(1, 1), b3 + hstep, voffB);
            PG8_WAIT_V(6); PG8_BAR; PG8_MMA(1, 1, At, B1); PG8_BAR;
            }
        }
        if constexpr (ALIGN_EPI) { if (wr == 0) PG8_BAR; }
        const bool keep_acc = (E.midk != 0 && cur.half == 0);
        if constexpr (!Epi::AFTER_DRAIN) { if (keep_acc) E.mid(acc, cur, wr, wc, fr, fq); else E(acc, cur, wr, wc, fr, fq); S.done(cur); }
        if (!has_next) break;
        if (!keep_acc) {
#pragma unroll
        for (int a = 0; a < 2; ++a)
#pragma unroll
            for (int b = 0; b < 2; ++b)
#pragma unroll
                for (int m = 0; m < 4; ++m)
#pragma unroll
                    for (int n = 0; n < 2; ++n) acc[a][b][m][n] = (f32x4){0.f, 0.f, 0.f, 0.f};
        }
        cur = nxt; cA = nA; cB = nB; ++ui;
        if constexpr (ALIGN_EPI) { if (wr == 1) PG8_BAR; }
    }
    PG8_WAIT_V(0);
    if constexpr (!ALIGN_EPI) { if (wr == 0) PG8_BAR; }
    PG8_BAR;
    if constexpr (Epi::AFTER_DRAIN) { E.fused(acc, cur, wr, wc, fr, fq, lds, wid, lane); S.done(cur); }
#undef PG8_SA
#undef PG8_SB
#undef PG8_STAGE
#undef PG8_LDA
#undef PG8_LDB
#undef PG8_MMA
#undef PG8_WAIT_V
#undef PG8_WAIT_L
#undef PG8_BAR
#undef PG8_SCHED
}
}
namespace attn_body {
using bf16=__hip_bfloat16;
using bf16x8=__attribute__((ext_vector_type(8)))short;
using s16x4=__attribute__((ext_vector_type(4)))short;
using f32x16=__attribute__((ext_vector_type(16)))float;
using u32x4=__attribute__((ext_vector_type(4)))unsigned;
constexpr int BATCH=16,NHEAD=8,NKVH=2,SEQ=4096,D=64,DM=NHEAD*D,KP=NKVH*D;
constexpr int NW=8,QBLK=32,QB=QBLK*NW,KVBLK=64,NQB=SEQ/QB;
constexpr int ATTN_PITCH=DM, ATTN_UNIT_ROWS=QB;
__device__ __forceinline__ int crow(int r,int hi){return (r&3)+8*(r>>2)+4*hi;}
#define SBAR() __builtin_amdgcn_sched_barrier(0)
__device__ __forceinline__ void cmask(f32x16&p0,f32x16&p1,int jb,int qrel,int hi){
  const float NEG=-INFINITY; int kb=64*jb+4*hi;
  #pragma unroll
  for(int r=0;r<16;++r){int kv=kb+(r&3)+8*(r>>2); if(kv>qrel)p0[r]=NEG; if(kv+32>qrel)p1[r]=NEG;}
}

constexpr int NSLOT=3, SLOTB=8192;
constexpr int LDS_K=0, LDS_V=NSLOT*SLOTB, LDS_WS=2*NSLOT*SLOTB, LDS_OST=LDS_WS+NW*64*4, LDS_BYTES=LDS_OST+NW*4096;
constexpr float C2=0.125f*1.4426950408889634f;
__device__ __forceinline__ void glds16(const void*gsrc,unsigned lds_dst){unsigned keep;
  asm volatile("s_mov_b32 %0, m0\n\ts_mov_b32 m0, %2\n\ts_nop 0\n\tglobal_load_lds_dwordx4 %1, off\n\ts_mov_b32 m0, %0":"=&s"(keep):"v"(gsrc),"s"(lds_dst):"memory");}
__device__ __forceinline__ float max3f(float a,float b,float c){float r;asm("v_max3_f32 %0, %1, %2, %3":"=v"(r):"v"(a),"v"(b),"v"(c));return r;}
__device__ __forceinline__ float max2f(float a,float b){float r;asm("v_max_f32_e32 %0, %1, %2":"=v"(r):"v"(a),"v"(b));return r;}
__device__ __forceinline__ float fadd_s(float a,float b){float r;asm("v_add_f32_e32 %0, %1, %2":"=v"(r):"v"(a),"v"(b));return r;}
__device__ __forceinline__ float fsub_s(float a,float b){float r;asm("v_sub_f32_e32 %0, %1, %2":"=v"(r):"v"(a),"v"(b));return r;}
typedef float f32x2_t __attribute__((ext_vector_type(2))); typedef __bf16 bf16x2_t __attribute__((ext_vector_type(2)));
__device__ __forceinline__ unsigned cvtpk_s(float lo,float hi){f32x2_t v={lo,hi};bf16x2_t b=__builtin_convertvector(v,bf16x2_t);return __builtin_bit_cast(unsigned,b);}
#define WAIT_BAR(N) asm volatile("s_waitcnt vmcnt(" #N ") lgkmcnt(0)\n\ts_barrier":::"memory")

__device__ __forceinline__ void qkt(f32x16&p0,f32x16&p1,const char*Kslot,const bf16x8*qr,const f32x16&negm,int r32,int hi){
  const char*kb=Kslot+hi*1024+r32*16;
  #pragma unroll
  for(int d0=0;d0<4;++d0){
    const bf16x8 b0=*reinterpret_cast<const bf16x8*>(kb+d0*2048);
    const bf16x8 b1=*reinterpret_cast<const bf16x8*>(kb+d0*2048+512);
    if(d0==0){p0=__builtin_amdgcn_mfma_f32_32x32x16_bf16(b0,qr[0],negm,0,0,0);p1=__builtin_amdgcn_mfma_f32_32x32x16_bf16(b1,qr[0],negm,0,0,0);}
    else{p0=__builtin_amdgcn_mfma_f32_32x32x16_bf16(b0,qr[d0],p0,0,0,0);p1=__builtin_amdgcn_mfma_f32_32x32x16_bf16(b1,qr[d0],p1,0,0,0);}}
}
typedef __attribute__((address_space(3))) const char* lds_cptr;
typedef short v4i16_t __attribute__((ext_vector_type(4)));
__device__ __forceinline__ void kload8(bf16x8*kf,lds_cptr kp){
  kf[0]=*(const __attribute__((address_space(3))) bf16x8*)(kp);      kf[1]=*(const __attribute__((address_space(3))) bf16x8*)(kp+512);
  kf[2]=*(const __attribute__((address_space(3))) bf16x8*)(kp+2048); kf[3]=*(const __attribute__((address_space(3))) bf16x8*)(kp+2560);
  kf[4]=*(const __attribute__((address_space(3))) bf16x8*)(kp+4096); kf[5]=*(const __attribute__((address_space(3))) bf16x8*)(kp+4608);
  kf[6]=*(const __attribute__((address_space(3))) bf16x8*)(kp+6144); kf[7]=*(const __attribute__((address_space(3))) bf16x8*)(kp+6656);
}
__device__ __forceinline__ void kload2(bf16x8*kf,lds_cptr kp,int j){ kf[2*j]=*(const __attribute__((address_space(3))) bf16x8*)(kp+j*2048); kf[2*j+1]=*(const __attribute__((address_space(3))) bf16x8*)(kp+j*2048+512); }
__device__ __forceinline__ s16x4 vtr(lds_cptr p){ return __builtin_bit_cast(s16x4,__builtin_amdgcn_ds_read_tr16_b64_v4i16((__attribute__((address_space(3))) v4i16_t*)p)); }
__device__ __forceinline__ float rowmax(const f32x16&p0,const f32x16&p1){
  float a=max3f(p0[0],p0[1],p1[0]),b=max3f(p0[2],p0[3],p1[1]);a=max3f(a,p1[2],p1[3]);
  #pragma unroll
  for(int r=4;r<16;r+=4){a=max3f(a,p0[r],p0[r+1]);b=max3f(b,p0[r+2],p0[r+3]);a=max3f(a,p1[r],p1[r+1]);b=max3f(b,p1[r+2],p1[r+3]);}
  const float m=max2f(a,b);
  auto rr=__builtin_amdgcn_permlane32_swap(__float_as_uint(m),__float_as_uint(m),false,false);
  return max2f(__uint_as_float(rr[0]),__uint_as_float(rr[1]));
}
__device__ __forceinline__ void pv(f32x16*o,int vb,bf16x8 pa0,bf16x8 pa1,bf16x8 pa2,bf16x8 pa3){
  #pragma unroll
  for(int d0=0;d0<2;++d0){s16x4 lo[4],hi[4];
    #pragma unroll
    for(int ks=0;ks<4;++ks){
      asm volatile("ds_read_b64_tr_b16 %0,%1 offset:%c2":"=&v"(lo[ks]):"v"(vb),"i"(d0*4096+ks*1024):"memory");
      asm volatile("ds_read_b64_tr_b16 %0,%1 offset:%c2":"=&v"(hi[ks]):"v"(vb),"i"(d0*4096+ks*1024+512):"memory");}
    asm volatile("s_waitcnt lgkmcnt(0)":::"memory");SBAR();
    #define PK(k) (bf16x8){lo[k][0],lo[k][1],lo[k][2],lo[k][3],hi[k][0],hi[k][1],hi[k][2],hi[k][3]}
    o[d0]=__builtin_amdgcn_mfma_f32_32x32x16_bf16(pa0,PK(0),o[d0],0,0,0);
    o[d0]=__builtin_amdgcn_mfma_f32_32x32x16_bf16(pa1,PK(1),o[d0],0,0,0);
    o[d0]=__builtin_amdgcn_mfma_f32_32x32x16_bf16(pa2,PK(2),o[d0],0,0,0);
    o[d0]=__builtin_amdgcn_mfma_f32_32x32x16_bf16(pa3,PK(3),o[d0],0,0,0);
    #undef PK
  }
}

#ifndef ATTN_STORE16
#define ATTN_STORE16(p,v) (*(u32x4*)(p)=(v))
#endif
template<int THRL> __device__ __forceinline__ void attn_unit(int b,int h,int qb,const bf16*Q,const bf16*__restrict__ K,const bf16*__restrict__ V,bf16*O,char*shm){
  int tid_o=threadIdx.x; asm volatile("":"+v"(tid_o)); const int tid=tid_o,lane=tid&63,r32=lane&31,hi=lane>>5; const int wid=__builtin_amdgcn_readfirstlane(tid>>6);
  const long rowbase=(long)b*SEQ; const int q0=qb*QB;
  const bf16*Qw=Q+(rowbase+q0+wid*QBLK)*DM+h*D;
  const bf16*Kh=K+rowbase*KP+(h>>2)*D,*Vh=V+rowbase*KP+(h>>2)*D;
  const unsigned lds0=(unsigned)(uintptr_t)shm;
  float*wsf=(float*)(shm+LDS_WS)+wid*64;
  const bf16*ksrc=Kh+(long)lane*KP+wid*8;
  const bf16*vsrc=Vh+(long)(16*(wid&3)+(lane>>2))*KP+(wid>>2)*32+(lane&3)*8;
  const unsigned kdst=lds0+LDS_K+wid*1024, vdst=lds0+LDS_V+wid*1024;
  #define DMA_K(t,slot) glds16(ksrc+(long)(t)*KVBLK*KP,(unsigned)__builtin_amdgcn_readfirstlane(kdst+(slot)))
  #define DMA_V(t,slot) glds16(vsrc+(long)(t)*KVBLK*KP,(unsigned)__builtin_amdgcn_readfirstlane(vdst+(slot)))
  const int vb0=(int)(lds0+LDS_V)+((lane>>4)&1)*32+(lane&3)*8+(4*hi+((lane&15)>>2))*64;
  const char*Kbase=shm+LDS_K; bf16x8 kf[8];
  const lds_cptr shm3=(lds_cptr)shm; const lds_cptr kp0=shm3+LDS_K+hi*1024+r32*16; const lds_cptr vp0=shm3+LDS_V+((lane>>4)&1)*32+(lane&3)*8+(4*hi+((lane&15)>>2))*64;
  const int NT=SEQ/KVBLK;
  DMA_K(0,0);DMA_V(0,0);DMA_K(1,SLOTB);
  bf16x8 qr[4];
  #pragma unroll
  for(int d0=0;d0<4;++d0)qr[d0]=*reinterpret_cast<const bf16x8*>(&Qw[(long)r32*DM+d0*16+hi*8]);
  float mhat=0.f,l_reg=0.f;f32x16 o[2];o[0]=f32x16{};o[1]=f32x16{};f32x16 negm=f32x16{};asm volatile("":"+v"(negm));
  const int qrel=wid*QBLK+r32;
  #define CMASK(P0,P1,t) do{}while(0)
  bool resc=false;
  #define START(P0,P1) do{ const float rm=rowmax(P0,P1); resc=false; \
    { const float dl=rm; mhat=fadd_s(mhat,dl); \
      _Pragma("unroll") for(int r=0;r<16;++r){P0[r]=fsub_s(P0[r],dl);P1[r]=fsub_s(P1[r],dl);} \
      _Pragma("unroll") for(int r=0;r<16;++r)negm[r]=-mhat; asm volatile("":"+v"(negm)); } \
    _Pragma("unroll") for(int r=0;r<16;++r)P0[r]=__builtin_amdgcn_exp2f(P0[r]); }while(0)
  #define RESC() do{ if(resc){ asm volatile("s_waitcnt lgkmcnt(0)":::"memory"); \
      _Pragma("unroll") for(int d_=0;d_<2;++d_) _Pragma("unroll") for(int r=0;r<16;++r)o[d_][r]*=wsf[crow(r,hi)]; } }while(0)
  f32x16 pA0,pA1,pB0,pB1;
  int sl_prev=0,sl_cur=0,sl_next=SLOTB;
  #define ROT() do{sl_prev=sl_cur;sl_cur=sl_next;sl_next=(sl_next==(NSLOT-1)*SLOTB)?0:sl_next+SLOTB;}while(0)
  DMA_K(2,2*SLOTB);
  WAIT_BAR(3);
  qkt(pA0,pA1,Kbase,qr,negm,r32,hi);asm volatile("s_nop 15\n\ts_nop 7":"+v"(pA0),"+v"(pA1));CMASK(pA0,pA1,0);
  START(pA0,pA1);
  _Pragma("unroll") for(int r=0;r<16;++r)pA1[r]=__builtin_amdgcn_exp2f(pA1[r]);
  WAIT_BAR(0);
  DMA_K(3,0);DMA_V(1,SLOTB);
  ROT();
  kload8(kf,kp0+sl_cur);
  WAIT_BAR(2);
  s16x4 vlo[8],vhi[8]; u32x4 pw0,pw1,pw2,pw3;
  #define PKW(P,B) cvtpk_s(P[B],P[B+1])
  #define PAF(k) __builtin_bit_cast(bf16x8,pw##k)
  #define VFR(i) (bf16x8){vlo[i][0],vlo[i][1],vlo[i][2],vlo[i][3],vhi[i][0],vhi[i][1],vhi[i][2],vhi[i][3]}
  #define PIN(x) asm volatile("":"+v"(x))
  #define MX3(a,b,c) __builtin_fmaxf(__builtin_fmaxf((a),(b)),(c))
  #define GAPA(MF,A0,A1,A2,A3,W0,W1,PW) do{ MF; sacc+=A0; sacc+=A1; sacc+=A2; sacc+=A3; PIN(sacc); W0; W1; PIN(PW); SBAR(); }while(0)
  #define EX(v) __builtin_amdgcn_exp2f(v)
  #define GAPB(MF,X,B) do{ MF; X[B]=EX(X[B]); X[B+1]=EX(X[B+1]); X[B+2]=EX(X[B+2]); X[B+3]=EX(X[B+3]); PIN(X); SBAR(); }while(0)
  #define VRD(i) do{ vlo[i]=vtr(vp_+(((i)>>2)*4096+((i)&3)*1024)); vhi[i]=vtr(vp_+(((i)>>2)*4096+((i)&3)*1024+512)); }while(0)
  #define KRD(G,j) do{ if(G){ kload2(kf,kp0+sl_next,j); SBAR(); } }while(0)
  #define STEP(C0,C1,P0,P1,t,GK,GV,GL) do{ SBAR(); \
    const lds_cptr vp_=vp0+sl_prev; \
    VRD(0); SBAR(); float sacc=(P0[0]+P0[1]); \
    GAPA(C0=__builtin_amdgcn_mfma_f32_32x32x16_bf16(kf[0],qr[0],negm,0,0,0), P0[2],P0[3],P0[4],P0[5],     pw0[0]=PKW(P0,0), pw0[1]=PKW(P0,2), pw0); \
    VRD(4); SBAR(); GAPA(C1=__builtin_amdgcn_mfma_f32_32x32x16_bf16(kf[1],qr[0],negm,0,0,0), P0[6],P0[7],P0[8],P0[9],     pw0[2]=PKW(P0,4), pw0[3]=PKW(P0,6), pw0); \
    VRD(1); SBAR(); GAPA(C0=__builtin_amdgcn_mfma_f32_32x32x16_bf16(kf[2],qr[1],C0,0,0,0),   P0[10],P0[11],P0[12],P0[13], pw1[0]=PKW(P0,8), pw1[1]=PKW(P0,10), pw1); \
    VRD(5); SBAR(); GAPA(C1=__builtin_amdgcn_mfma_f32_32x32x16_bf16(kf[3],qr[1],C1,0,0,0),   P0[14],P0[15],P1[0],P1[1],   pw1[2]=PKW(P0,12),pw1[3]=PKW(P0,14), pw1); \
    VRD(2); SBAR(); GAPA(C0=__builtin_amdgcn_mfma_f32_32x32x16_bf16(kf[4],qr[2],C0,0,0,0),   P1[2],P1[3],P1[4],P1[5],     pw2[0]=PKW(P1,0), pw2[1]=PKW(P1,2), pw2); \
    VRD(6); SBAR(); GAPA(C1=__builtin_amdgcn_mfma_f32_32x32x16_bf16(kf[5],qr[2],C1,0,0,0),   P1[6],P1[7],P1[8],P1[9],     pw2[2]=PKW(P1,4), pw2[3]=PKW(P1,6), pw2); \
    VRD(3); SBAR(); GAPA(C0=__builtin_amdgcn_mfma_f32_32x32x16_bf16(kf[6],qr[3],C0,0,0,0),   P1[10],P1[11],P1[12],P1[13], pw3[0]=PKW(P1,8), pw3[1]=PKW(P1,10), pw3); \
    VRD(7); SBAR(); GAPA(C1=__builtin_amdgcn_mfma_f32_32x32x16_bf16(kf[7],qr[3],C1,0,0,0),   P1[14],P1[15],0.f,0.f,       pw3[2]=PKW(P1,12),pw3[3]=PKW(P1,14), pw3); \
    l_reg+=sacc; \
    if(GK){DMA_K((t)+3,sl_cur);} if(GV){DMA_V((t)+1,sl_next);} \
    CMASK(C0,C1,t); \
    { float a=MX3(C0[0],C0[1],C1[0]),b=MX3(C0[2],C0[3],C1[1]); a=MX3(a,C1[2],C1[3]); \
      _Pragma("unroll") for(int r=4;r<16;r+=4){a=MX3(a,C0[r],C0[r+1]);b=MX3(b,C0[r+2],C0[r+3]);a=MX3(a,C1[r],C1[r+1]);b=MX3(b,C1[r+2],C1[r+3]);} \
      float rm=__builtin_fmaxf(a,b); { auto rr=__builtin_amdgcn_permlane32_swap(__float_as_uint(rm),__float_as_uint(rm),false,false); rm=__builtin_fmaxf(__uint_as_float(rr[0]),__uint_as_float(rr[1])); } \
      resc=false; \
      if(__builtin_expect(__any(rm>(float)THRL),0)){ const float dl=__builtin_fmaxf(rm,0.f); mhat+=dl; \
        _Pragma("unroll") for(int r=0;r<16;++r){C0[r]-=dl;C1[r]-=dl;} \
        _Pragma("unroll") for(int r=0;r<16;++r)negm[r]=-mhat; asm volatile("":"+v"(negm)); \
        const float f=__builtin_amdgcn_exp2f(-dl); l_reg*=f; if(hi==0)wsf[r32]=f; resc=true; } } \
    SBAR(); \
    GAPB(o[0]=__builtin_amdgcn_mfma_f32_32x32x16_bf16(PAF(0),VFR(0),o[0],0,0,0), C0,0); \
    GAPB(o[1]=__builtin_amdgcn_mfma_f32_32x32x16_bf16(PAF(0),VFR(4),o[1],0,0,0), C0,4); \
    KRD(GL,0); GAPB(o[0]=__builtin_amdgcn_mfma_f32_32x32x16_bf16(PAF(1),VFR(1),o[0],0,0,0), C0,8); \
    KRD(GL,1); GAPB(o[1]=__builtin_amdgcn_mfma_f32_32x32x16_bf16(PAF(1),VFR(5),o[1],0,0,0), C0,12); \
    KRD(GL,2); GAPB(o[0]=__builtin_amdgcn_mfma_f32_32x32x16_bf16(PAF(2),VFR(2),o[0],0,0,0), C1,0); \
    KRD(GL,3); GAPB(o[1]=__builtin_amdgcn_mfma_f32_32x32x16_bf16(PAF(2),VFR(6),o[1],0,0,0), C1,4); \
    GAPB(o[0]=__builtin_amdgcn_mfma_f32_32x32x16_bf16(PAF(3),VFR(3),o[0],0,0,0), C1,8); \
    GAPB(o[1]=__builtin_amdgcn_mfma_f32_32x32x16_bf16(PAF(3),VFR(7),o[1],0,0,0), C1,12); \
    }while(0)
  int t=1;
  #undef CMASK
  #define CMASK(P0,P1,t) do{}while(0)
  for(;t+5<NT;t+=2){
    STEP(pB0,pB1,pA0,pA1,t,true,true,true);     WAIT_BAR(2); RESC(); ROT();
    STEP(pA0,pA1,pB0,pB1,t+1,true,true,true);   WAIT_BAR(2); RESC(); ROT();
  }
  #undef CMASK
  #define CMASK(P0,P1,t) do{}while(0)
  #define ENDW(tt) do{ if((tt)+3<NT){WAIT_BAR(2);} else if((tt)+2<NT){WAIT_BAR(1);} else {WAIT_BAR(0);} }while(0)
  for(;t+1<NT;t+=2){
    STEP(pB0,pB1,pA0,pA1,t,(t+3<NT),(t+1<NT),(t+1<NT));       ENDW(t);   RESC(); ROT();
    STEP(pA0,pA1,pB0,pB1,t+1,(t+4<NT),(t+2<NT),(t+2<NT));     ENDW(t+1); RESC(); ROT();
  }
  STEP(pB0,pB1,pA0,pA1,NT-1,false,false,false); RESC();
  { float sacc=pB0[0]+pB0[1]; _Pragma("unroll") for(int r=2;r<16;++r)sacc+=pB0[r]; _Pragma("unroll") for(int r=0;r<16;++r)sacc+=pB1[r]; l_reg+=sacc;
    pw0=(u32x4){PKW(pB0,0),PKW(pB0,2),PKW(pB0,4),PKW(pB0,6)};pw1=(u32x4){PKW(pB0,8),PKW(pB0,10),PKW(pB0,12),PKW(pB0,14)};pw2=(u32x4){PKW(pB1,0),PKW(pB1,2),PKW(pB1,4),PKW(pB1,6)};pw3=(u32x4){PKW(pB1,8),PKW(pB1,10),PKW(pB1,12),PKW(pB1,14)};
    SBAR(); pv(o,vb0+sl_cur,PAF(0),PAF(1),PAF(2),PAF(3)); }
  #undef PKW
  #undef PAF
  #undef VFR
  #undef PIN
  #undef MX3
  #undef GAPA
  #undef GAPB
  #undef EX
  #undef VRD
  #undef KRD
  #undef STEP
  #undef ENDW
  {auto rr=__builtin_amdgcn_permlane32_swap(__float_as_uint(l_reg),__float_as_uint(l_reg),false,false);l_reg=__uint_as_float(rr[0])+__uint_as_float(rr[1]);}
  if(hi==0)wsf[32+r32]=l_reg;asm volatile("s_waitcnt lgkmcnt(0)":::"memory");
  float rli[16];
  #pragma unroll
  for(int r=0;r<16;++r)rli[r]=__builtin_amdgcn_rcpf(wsf[32+crow(r,hi)]);
  bf16*Ow=O+(rowbase+q0+wid*QBLK)*DM+h*D;
  { bf16*stg=(bf16*)(shm+LDS_OST)+wid*2048;
    #pragma unroll
    for(int r=0;r<16;++r){const int orow=crow(r,hi);
      #pragma unroll
      for(int d0=0;d0<2;++d0)stg[orow*64+d0*32+r32]=__float2bfloat16(o[d0][r]*rli[r]);}
    asm volatile("s_waitcnt lgkmcnt(0)":::"memory");
    #pragma unroll
    for(int i=0;i<4;++i){const int row=i*8+(lane>>3),ch=lane&7; const u32x4 v=*(const u32x4*)(stg+row*64+ch*8); ATTN_STORE16(Ow+(long)row*DM+ch*8,v);} }
  asm volatile("s_waitcnt lgkmcnt(0)\n\ts_barrier":::"memory");
  #undef DMA_K
  #undef DMA_V
  #undef CMASK
  #undef START
  #undef RESC
  #undef ROT
}
constexpr int ATTN_LDS_BYTES=LDS_BYTES;
struct AttnTensors { const bf16* Q; const bf16* K; const bf16* V; bf16* O; };
struct AttnUnit { int bh; int qb; };
struct StaticOrder {
  int vcu, G;
  __device__ __forceinline__ explicit StaticOrder(int grid,int block):vcu((grid%8==0)?(block%8)*(grid/8)+block/8:block),G(grid){}
  __device__ __forceinline__ bool next(int i,AttnUnit&u)const{ const int idx=i*G+vcu; if(idx>=BATCH*NHEAD*NQB)return false; const int pair=idx/(4*NQB), r=idx%(4*NQB); u.bh=(pair>>1)*NHEAD+(pair&1)*4+r/NQB; u.qb=r%NQB; return true; }
  __device__ __forceinline__ void a_ready(const AttnUnit&)const{}
  __device__ __forceinline__ void done(const AttnUnit&)const{}
};
template<class Sched,int THRL=8> __device__ __forceinline__ void attn_phase(char*lds,const AttnTensors&T,const Sched&S){
  AttnUnit u;
  for(int i=0;S.next(i,u);++i){ S.a_ready(u); attn_unit<THRL>(u.bh/NHEAD,u.bh%NHEAD,u.qb,T.Q,T.K,T.V,T.O,lds); S.done(u); }
}
#undef SBAR
#undef WAIT_BAR
}
#define GAS __attribute__((address_space(1)))
#define LAS __attribute__((address_space(3)))
typedef unsigned short bf16;
typedef unsigned v4u __attribute__((ext_vector_type(4)));
typedef unsigned v2u __attribute__((ext_vector_type(2)));
typedef float f32x4 __attribute__((ext_vector_type(4)));
typedef float f32x2 __attribute__((ext_vector_type(2)));
typedef short bf16x8 __attribute__((ext_vector_type(8)));
typedef bf16x8 bf16x8_u2 __attribute__((aligned(2)));
constexpr int NWAVES = 8, NTHR = 512;
constexpr int LDS_BYTES = 161792;
constexpr int ZS = 4496, ZO = 192;
constexpr int HY_F_OFF = 16 * ZS * 2;
constexpr int HY_RED_OFF = HY_F_OFF + 16384;
constexpr int BARST_OFF = 161280;
constexpr size_t CTL_ZERO_BYTES = 16384;

__device__ __forceinline__ unsigned f2bf(float f) { unsigned u = __builtin_bit_cast(unsigned, f); return (u + 0x7fffu + ((u >> 16) & 1u)) >> 16; }
__device__ __forceinline__ unsigned pk2(float lo, float hi) { return f2bf(lo) | (f2bf(hi) << 16); }
__device__ __forceinline__ float bflo(unsigned w) { return __uint_as_float(w << 16); }
__device__ __forceinline__ float bfhi(unsigned w) { return __uint_as_float(w & 0xffff0000u); }
__device__ __forceinline__ float bf1(bf16 h) { return __uint_as_float((unsigned)h << 16); }
__device__ __forceinline__ float wave_sum(float v) {
#pragma unroll
    for (int o = 1; o < 64; o <<= 1) v += __shfl_xor(v, o);
    return v;
}
__device__ __forceinline__ float sq4v(f32x4 v) { return (v[0] * v[0] + v[1] * v[1]) + (v[2] * v[2] + v[3] * v[3]); }
#define LDS_WAIT() asm volatile("s_waitcnt lgkmcnt(0)" ::: "memory")

#define XB_TMO      128
#define XB_XCNT(j)  (256  + 64 * (j))
#define XB_XSUB(j)  (1280 + 64 * (j))
#define XB_XGEN(j)  (2304 + 64 * (j))
#define XB_TOP      3328
#define XB_TOPGEN   3392
#define XCD_BAR_WORDS 3456
#define XB_SPIN_CAP (1u << 18)

__device__ __forceinline__ unsigned xb_ld(unsigned* p)              { return __hip_atomic_load(p, __ATOMIC_RELAXED, __HIP_MEMORY_SCOPE_AGENT); }
__device__ __forceinline__ unsigned xb_add(unsigned* p, unsigned v) { return __hip_atomic_fetch_add(p, v, __ATOMIC_RELAXED, __HIP_MEMORY_SCOPE_AGENT); }
__device__ __forceinline__ unsigned xb_xcc_id() { return (unsigned)__builtin_amdgcn_s_getreg((3 << 11) | 20) & 0xFu; }
#define XB_SPIN(cond, bar) do { unsigned _sp = 0; while (cond) { __builtin_amdgcn_s_sleep(1); \
    if ((++_sp & 255u) == 0u) { if (xb_ld(&(bar)[XB_TMO])) break; if (_sp > XB_SPIN_CAP) { atomicAdd(&(bar)[XB_TMO], 1u); break; } } } } while (0)

struct XcdBarrier {
    unsigned* bar; unsigned x;
    volatile LAS unsigned* st;
};

__device__ __forceinline__ XcdBarrier xcd_barrier_post(unsigned* bar, volatile LAS unsigned* st) {
    XcdBarrier b; b.bar = bar; b.x = xb_xcc_id(); b.st = st;
    if (threadIdx.x == 0) (void)xb_add(&bar[XB_XCNT(b.x)], 1u);
    return b;
}
__device__ __forceinline__ void xcd_barrier_complete(unsigned* bar, unsigned x, unsigned& nloc, unsigned& nx) {
    const unsigned G = gridDim.x * gridDim.y * gridDim.z;
    unsigned sum, cnt, mine, sp = 0u;
    for (;;) {
        sum = 0u; cnt = 0u; mine = 0u;
#pragma unroll
        for (unsigned j = 0; j < 16; ++j) { const unsigned c = xb_ld(&bar[XB_XCNT(j)]); sum += c; cnt += (c > 0u) ? 1u : 0u; mine = (j == x) ? c : mine; }
        if (sum == G) break;
        __builtin_amdgcn_s_sleep(1);
        if ((++sp & 255u) == 0u) { if (xb_ld(&bar[XB_TMO])) break; if (sp > XB_SPIN_CAP) { atomicAdd(&bar[XB_TMO], 1u); break; } }
    }
    nloc = mine > 0u ? mine : 1u; nx = cnt > 0u ? cnt : 1u;
}

__device__ __forceinline__ void xcd_barrier(const XcdBarrier& b) {
    asm volatile("s_waitcnt vmcnt(0)" ::: "memory");
    __syncthreads();
    if (threadIdx.x == 0) {
        unsigned* bar = b.bar;
        __builtin_amdgcn_s_waitcnt(0);
        unsigned nloc = b.st[0], nx = b.st[1];
        if (nloc == 0u) { xcd_barrier_complete(bar, b.x, nloc, nx); b.st[0] = nloc; b.st[1] = nx; }
        const unsigned old = xb_add(&bar[XB_XSUB(b.x)], 1u);
        const unsigned gen = old / nloc;
        if (old + 1u == (gen + 1u) * nloc) {
            __builtin_amdgcn_fence(__ATOMIC_RELEASE, "agent");
            asm volatile("s_waitcnt vmcnt(0)" ::: "memory");
            const unsigned og = xb_add(&bar[XB_TOP], 1u);
            const unsigned tg = og / nx;
            if (og + 1u == (tg + 1u) * nx) xb_add(&bar[XB_TOPGEN], 1u);
            else XB_SPIN(xb_ld(&bar[XB_TOPGEN]) == tg, bar);
            __builtin_amdgcn_fence(__ATOMIC_ACQUIRE, "agent");
            xb_add(&bar[XB_XGEN(b.x)], 1u);
            asm volatile("s_waitcnt vmcnt(0)" ::: "memory");
        } else {
            XB_SPIN(xb_ld(&bar[XB_XGEN(b.x)]) == gen, bar);
            __builtin_amdgcn_fence(__ATOMIC_ACQUIRE, "agent");
            asm volatile("s_waitcnt vmcnt(0)" ::: "memory");
        }
    }
    __syncthreads();
}

struct Frame { LAS unsigned char* lds; int tid, lane, wave, vcu, G; };

__device__ __forceinline__ void transpose_item(const float* W, int K, int N, bf16* WT, int grp, int stride, int off, const float* g, LAS float* scr, int item, int lane) {
    const int nblk = N / 32, kb = item / nblk, nb = item % nblk, k0 = 64 * kb, n0 = 32 * nb;
#pragma unroll 8
    for (int i = 0; i < 32; ++i) { const int kk = 2 * i + (lane >> 5); float v = W[(size_t)(k0 + kk) * N + n0 + (lane & 31)]; if (g) v *= g[k0 + kk]; scr[kk * 33 + (lane & 31)] = v; }
    LDS_WAIT(); asm volatile("" ::: "memory");
    const int c = lane & 7;
#pragma unroll
    for (int j = 0; j < 4; ++j) { const int n = (lane >> 3) + 8 * j; const LAS float* s = scr + (8 * c) * 33 + n; const int ng = n0 + n, row = (ng / grp) * stride + off + (ng % grp);
        v4u o; o.x = pk2(s[0 * 33], s[1 * 33]); o.y = pk2(s[2 * 33], s[3 * 33]); o.z = pk2(s[4 * 33], s[5 * 33]); o.w = pk2(s[6 * 33], s[7 * 33]);
        *(v4u*)(WT + (size_t)row * K + k0 + 8 * c) = o; }
    LDS_WAIT(); asm volatile("" ::: "memory");
}

struct Args { const float* in[35]; float* out; unsigned char* ws; int step_lo, step_hi; };
#define CAS __attribute__((address_space(4)))
__device__ __forceinline__ const float* karg_in(int k) { CAS const char* ka = (CAS const char*)__builtin_amdgcn_kernarg_segment_ptr(); asm volatile("" : "+s"(ka)); typedef const float* cfp_t; return *(CAS const cfp_t*)(ka + 8 * k); }
__device__ __forceinline__ unsigned char* karg_ws() { CAS const char* ka = (CAS const char*)__builtin_amdgcn_kernarg_segment_ptr(); asm volatile("" : "+s"(ka)); typedef unsigned char* ucp_t; return *(CAS const ucp_t*)(ka + 288); }
__device__ __forceinline__ float* karg_out() { CAS const char* ka = (CAS const char*)__builtin_amdgcn_kernarg_segment_ptr(); asm volatile("" : "+s"(ka)); typedef float* fp_t; return *(CAS const fp_t*)(ka + 280); }
#define IN(k) karg_in(k)

__device__ __forceinline__ void prologue(const Frame& F) {
    unsigned char* ws = karg_ws();
    LAS float* scr = (LAS float*)(F.lds + F.wave * 16384);
    const int gw = F.vcu * NWAVES + F.wave, NGW = F.G * NWAVES, lane = F.lane;
    constexpr int I_G = (DM_ / 64) * (FF / 32), I_D = (FF / 64) * (DM_ / 32), I_IN = (DM_ / 64) * (INC / 32), I_HO = (HYW / 64) * (DM_ / 32), I_O = (DM_ / 64) * (DM_ / 32), I_PP = (PLE / 64) * (DM_ / 32);
    constexpr int NITEMS = 4 * I_G + 2 * I_D + I_IN + 2 * I_HO + 2 * I_O + I_PP;
    const int BIGN = 1 << 30;
    for (int it = gw; it < NITEMS; it += NGW) {
        int r = it;
        if (r < I_G) { transpose_item(IN(4), DM_, FF, (bf16*)(ws + WS_GU1), 128, 256, 0, IN(2), scr, r, lane); continue; } r -= I_G;
        if (r < I_G) { transpose_item(IN(5), DM_, FF, (bf16*)(ws + WS_GU1), 128, 256, 128, IN(2), scr, r, lane); continue; } r -= I_G;
        if (r < I_D) { transpose_item(IN(6), FF, DM_, (bf16*)(ws + WS_D1), BIGN, 0, 0, nullptr, scr, r, lane); continue; } r -= I_D;
        if (r < I_IN) { transpose_item(IN(9), DM_, INC, (bf16*)(ws + WS_IN), BIGN, 0, 0, IN(7), scr, r, lane); continue; } r -= I_IN;
        if (r < I_HO) { transpose_item(IN(23), HYW, DM_, (bf16*)(ws + WS_HYO), BIGN, 0, 0, nullptr, scr, r, lane); continue; } r -= I_HO;
        if (r < I_HO) { transpose_item(IN(24), HYW, DM_, (bf16*)(ws + WS_ATO), BIGN, 0, 0, nullptr, scr, r, lane); continue; } r -= I_HO;
        if (r < I_O) { transpose_item(IN(25), DM_, DM_, (bf16*)(ws + WS_OUT), BIGN, 0, 0, nullptr, scr, r, lane); continue; } r -= I_O;
        if (r < I_G) { transpose_item(IN(28), DM_, FF, (bf16*)(ws + WS_GU2), 128, 256, 0, IN(26), scr, r, lane); continue; } r -= I_G;
        if (r < I_G) { transpose_item(IN(29), DM_, FF, (bf16*)(ws + WS_GU2), 128, 256, 128, IN(26), scr, r, lane); continue; } r -= I_G;
        if (r < I_D) { transpose_item(IN(30), FF, DM_, (bf16*)(ws + WS_D2), BIGN, 0, 0, nullptr, scr, r, lane); continue; } r -= I_D;
        if (r < I_O) { transpose_item(IN(33), DM_, DM_, (bf16*)(ws + WS_PG), BIGN, 0, 0, IN(31), scr, r, lane); continue; } r -= I_O;
        transpose_item(IN(34), PLE, DM_, (bf16*)(ws + WS_PP), BIGN, 0, 0, nullptr, scr, r, lane);
    }
    { const float* x = IN(0); bf16* xb = (bf16*)(ws + WS_XB); float* rs = (float*)(ws + WS_RS);
      for (int row0 = gw; row0 < M; row0 += 2 * NGW) { f32x4 v[2][4];
#pragma unroll
          for (int u = 0; u < 2; ++u) { const int row = (row0 + u * NGW < M) ? row0 + u * NGW : row0; const f32x4* xr = (const f32x4*)(x + (size_t)row * DM_) + lane;
#pragma unroll
              for (int j = 0; j < 4; ++j) v[u][j] = xr[64 * j]; }
#pragma unroll
          for (int u = 0; u < 2; ++u) { const int row = row0 + u * NGW;
              if (row < M) { v2u* o8 = (v2u*)(xb + (size_t)row * DM_) + lane; float ss = 0.f;
#pragma unroll
                  for (int j = 0; j < 4; ++j) { v2u o; o.x = pk2(v[u][j][0], v[u][j][1]); o.y = pk2(v[u][j][2], v[u][j][3]); o8[64 * j] = o;
                      f32x4 xq; xq[0] = bflo(o.x); xq[1] = bfhi(o.x); xq[2] = bflo(o.y); xq[3] = bfhi(o.y); ss += sq4v(xq); }
                  ss = wave_sum(ss); if (lane == 0) rs[row] = 1.0f / sqrtf(ss * (1.0f / DM_) + EPS); } } } }
    { const float *w1 = IN(12), *b1 = IN(13), *f1 = IN(14), *w2 = IN(15), *b2 = IN(16), *f2 = IN(17); float* h2 = (float*)(ws + WS_H2);
      for (int t = gw; t < SEQ; t += NGW) {
          const float tl = (float)t * (1.0f / (float)(SEQ - 1)); const float wv = (float)(2.0 * 3.14159265358979323846 / SEQ) * (float)t;
          float z = 0.f;
          if (lane == 0) z = tl; else if (lane <= 32) { const int bi = (lane - 1) & 15; const float band = 1e-4f + (float)bi * ((15.0f - 1e-4f) / 15.0f); const float ang = wv * band; z = (lane <= 16) ? cosf(ang) : -sinf(ang); }
          float acc = b1[lane];
          for (int i = 0; i < 33; ++i) acc += __shfl(z, i) * w1[i * 64 + lane];
          const float h1 = sinf(f1[lane] * acc);
          float acc2 = b2[lane];
          for (int i = 0; i < 64; ++i) acc2 += __shfl(h1, i) * w2[i * 64 + lane];
          h2[t * 64 + lane] = sinf(f2[lane] * acc2); } }
    { f32x2* rope = (f32x2*)(ws + WS_ROPE);
      for (int idx = (F.vcu * NTHR + F.tid); idx < SEQ * 32; idx += F.G * NTHR) { const int t = idx >> 5, i = idx & 31; const float pos = (i < 16) ? (float)(t >> 6) : (float)(t & 63);
          const float inv = powf(10000.0f, -(float)(2 * (i & 15)) / 32.0f); const float ang = pos * inv; rope[idx] = (f32x2){cosf(ang), sinf(ang)}; } }
}

__device__ __forceinline__ void filter_cols(const Frame& F) {
    unsigned char* ws_ = karg_ws();
    const float* h2 = (const float*)(ws_ + WS_H2); const float* w3 = IN(18); const float* dl = IN(19); bf16* filt = (bf16*)(ws_ + WS_FILT);
    LAS float* sw = (LAS float*)F.lds; LAS float* red = sw + 128;
    for (int pr = blockIdx.x; pr < 2 * HYW; pr += F.G) {
        const int o = pr / HYW, c = pr % HYW, colf = o * 2 * HYW + c, colb = colf + HYW;
        if (F.tid < 128) sw[F.tid] = w3[(size_t)(F.tid & 63) * (4 * HYW) + (F.tid < 64 ? colf : colb)];
        __syncthreads();
        const float df = fabsf(dl[colf]), db = fabsf(dl[colb]);
        float hf[8], hb[8]; float s = 0.f;
#pragma unroll
        for (int i = 0; i < 8; ++i) { const int t = F.tid + NTHR * i; const f32x4* row = (const f32x4*)(h2 + (size_t)t * 64); float af = 0.f, ab = 0.f;
#pragma unroll
            for (int j = 0; j < 16; ++j) { const f32x4 v = row[j]; af += v[0] * sw[4 * j] + v[1] * sw[4 * j + 1] + v[2] * sw[4 * j + 2] + v[3] * sw[4 * j + 3];
                ab += v[0] * sw[64 + 4 * j] + v[1] * sw[64 + 4 * j + 1] + v[2] * sw[64 + 4 * j + 2] + v[3] * sw[64 + 4 * j + 3]; }
            const float tl = (float)t * (1.0f / (float)(SEQ - 1)); hf[i] = af * expf(-tl * df); hb[i] = ab * expf(-tl * db);
            s += (t == 0) ? fabsf(hf[i] + hb[i]) : (fabsf(hf[i]) + fabsf(hb[i]));  asm volatile("" ::: "memory"); }
        s = wave_sum(s); if (F.lane == 0) red[F.wave] = s;
        __syncthreads();
        float tot = 0.f;
#pragma unroll
        for (int w = 0; w < NWAVES; ++w) tot += red[w];
        const float inv = 1.0f / tot; bf16* Fp = filt + (size_t)pr * 8192;
#pragma unroll
        for (int i = 0; i < 8; ++i) { const int t = F.tid + NTHR * i;
            if (t == 0) { Fp[4095] = (bf16)f2bf((hf[i] + hb[i]) * inv); Fp[8191] = 0; }
            else { Fp[4095 - t] = (bf16)f2bf(hf[i] * inv); Fp[4095 + t] = (bf16)f2bf(hb[i] * inv); } }
        __syncthreads();
    }
}

__device__ __forceinline__ void elem_pass(const Frame& F, bf16* xb, const bf16* hb, const float* part, const float* gpost, float scale, float* xout, float* rsout, bool last) {
    const int gw = F.vcu * NWAVES + F.wave, NGW = F.G * NWAVES, lane = F.lane;
    f32x4 g[4];
#pragma unroll
    for (int j = 0; j < 4; ++j) g[j] = ((const f32x4*)gpost)[lane + 64 * j];
    for (int row0 = gw; row0 < M; row0 += 2 * NGW) {
        v2u xw[2][4], hw[2][4]; float pv[2];
#pragma unroll
        for (int u = 0; u < 2; ++u) { const int row = (row0 + u * NGW < M) ? row0 + u * NGW : row0;
            pv[u] = (lane < 16) ? part[(size_t)row * 16 + lane] : 0.f;
            const v2u* xr = (const v2u*)(xb + (size_t)row * DM_) + lane; const v2u* hr = (const v2u*)(hb + (size_t)row * DM_) + lane;
#pragma unroll
            for (int j = 0; j < 4; ++j) { xw[u][j] = xr[64 * j]; hw[u][j] = __builtin_nontemporal_load(hr + 64 * j); } }
#pragma unroll
        for (int u = 0; u < 2; ++u) { const int row = row0 + u * NGW;
            if (row < M) {
                const float rh = scale / sqrtf(wave_sum(pv[u]) * (1.0f / DM_) + EPS);
                v2u* xr = (v2u*)(xb + (size_t)row * DM_) + lane; f32x4* xo = (f32x4*)(xout + (size_t)row * DM_) + lane; float ss = 0.f;
#pragma unroll
                for (int j = 0; j < 4; ++j) { const v2u xv = xw[u][j], h = hw[u][j]; f32x4 x, hv;
                    x[0] = bflo(xv.x); x[1] = bfhi(xv.x); x[2] = bflo(xv.y); x[3] = bfhi(xv.y); hv[0] = bflo(h.x); hv[1] = bfhi(h.x); hv[2] = bflo(h.y); hv[3] = bfhi(h.y);
                    const f32x4 xn = x + hv * g[j] * rh;
                    if (last) __builtin_nontemporal_store(xn, xo + 64 * j);
                    else { v2u o; o.x = pk2(xn[0], xn[1]); o.y = pk2(xn[2], xn[3]); xr[64 * j] = o;
                           f32x4 xq; xq[0] = bflo(o.x); xq[1] = bfhi(o.x); xq[2] = bflo(o.y); xq[3] = bfhi(o.y); ss += sq4v(xq); } }
                if (!last) { ss = wave_sum(ss); if (lane == 0) rsout[row] = 1.0f / sqrtf(ss * (1.0f / DM_) + EPS); }
            } }
    }
}

__device__ __forceinline__ void qk_prep(const Frame& F) {
    unsigned char* ws_ = karg_ws();
    bf16* q = (bf16*)(ws_ + WS_Q); bf16* k = (bf16*)(ws_ + WS_K); const f32x2* rope = (const f32x2*)(ws_ + WS_ROPE); const float *qn = IN(21), *kn = IN(22);
    const int gt = F.vcu * NTHR + F.tid, sub = gt & 7; const int ngrp = F.G * NTHR / 8;
    for (int g0 = gt >> 3; g0 < M * 10; g0 += 4 * ngrp) {
        v4u wv[4];
#pragma unroll
        for (int u = 0; u < 4; ++u) { const int g = (g0 + u * ngrp < M * 10) ? g0 + u * ngrp : g0; const int tok = g / 10, hh = g - tok * 10;
            const bf16* p = (hh < 8 ? q + (size_t)tok * 512 + hh * 64 : k + (size_t)tok * 128 + (hh - 8) * 64) + sub * 8; wv[u] = *(const v4u*)p; }
#pragma unroll
        for (int u = 0; u < 4; ++u) { const int g = g0 + u * ngrp;
            if (g < M * 10) {
                const int tok = g / 10, hh = g - tok * 10; bf16* p = (hh < 8 ? q + (size_t)tok * 512 + hh * 64 : k + (size_t)tok * 128 + (hh - 8) * 64) + sub * 8;
                const v4u w = wv[u]; float x[8] = {bflo(w.x), bfhi(w.x), bflo(w.y), bfhi(w.y), bflo(w.z), bfhi(w.z), bflo(w.w), bfhi(w.w)};
                float ss = 0.f;
#pragma unroll
                for (int e = 0; e < 8; ++e) ss += x[e] * x[e];
                ss += __shfl_xor(ss, 1); ss += __shfl_xor(ss, 2); ss += __shfl_xor(ss, 4);
                const float r = 1.0f / sqrtf(ss * (1.0f / 64.0f) + EPS); const float* gn = (hh < 8 ? qn : kn) + sub * 8; const float sc = (hh < 8) ? QSCALE : 1.0f;
                const f32x2* rp = rope + (size_t)(tok & (SEQ - 1)) * 32 + sub * 4; float y[8];
#pragma unroll
                for (int e = 0; e < 4; ++e) { const float y0 = x[2 * e] * r * gn[2 * e], y1 = x[2 * e + 1] * r * gn[2 * e + 1]; const f32x2 cs = rp[e];
                    y[2 * e] = (y0 * cs.x - y1 * cs.y) * sc; y[2 * e + 1] = (y0 * cs.y + y1 * cs.x) * sc; }
                v4u o; o.x = pk2(y[0], y[1]); o.y = pk2(y[2], y[3]); o.z = pk2(y[4], y[5]); o.w = pk2(y[6], y[7]); *(v4u*)p = o;
            } }
    }
}

__device__ __forceinline__ void hyena_phase(const Frame& F) {
    unsigned char* ws_ = karg_ws();
    const bf16* hyT = (const bf16*)(ws_ + WS_HYT); const bf16* filt = (const bf16*)(ws_ + WS_FILT); bf16* yaT = (bf16*)(ws_ + WS_HB);
    const float *sw = IN(10), *sb = IN(11), *hbias = IN(20);
    LAS bf16* Z = (LAS bf16*)F.lds + ZO; LAS bf16* FL = (LAS bf16*)(F.lds + HY_F_OFF);
    const int tid = F.tid, lane = F.lane, w = F.wave, fr = lane & 15, fq = lane >> 4;
    for (int e = F.tid; e < 16 * 48; e += NTHR) { const int b = e / 48, j = e % 48; const int col = j < 24 ? -192 + 8 * j : 4096 + 8 * (j - 24); *(LAS v4u*)(Z + b * ZS + col) = (v4u){0u, 0u, 0u, 0u}; }
    __syncthreads();
    for (int c = F.vcu; c < HYW; c += F.G) {
        { const bf16* src = hyT + (size_t)c * M; const float w0 = sw[c], w1 = sw[3 * HYW + c], w2 = sw[6 * HYW + c], bb = sb[c];
          int tz = tid; asm volatile("" : "+v"(tz));
#pragma unroll 4
          for (int i = 0; i < 16; ++i) { const int qd = tz + NTHR * i, b = qd >> 9, t0 = (qd & 511) * 8; const bf16* p = src + b * SEQ + t0; const v4u v = *(const v4u*)p;
              float x[10]; { const float xm = bf1(p[-1]), xp = bf1(p[8]); x[0] = t0 > 0 ? xm : 0.f; x[9] = (t0 + 8 < SEQ) ? xp : 0.f; }
              x[1] = bflo(v.x); x[2] = bfhi(v.x); x[3] = bflo(v.y); x[4] = bfhi(v.y); x[5] = bflo(v.z); x[6] = bfhi(v.z); x[7] = bflo(v.w); x[8] = bfhi(v.w);
              float y[8];
#pragma unroll
              for (int e = 0; e < 8; ++e) y[e] = w0 * x[e] + w1 * x[e + 1] + w2 * x[e + 2] + bb;
              v4u o; o.x = pk2(y[0], y[1]); o.y = pk2(y[2], y[3]); o.z = pk2(y[4], y[5]); o.w = pk2(y[6], y[7]); *(LAS v4u*)(Z + b * ZS + t0) = o; } }
        for (int o = 0; o < 2; ++o) {
            { int tf = tid; asm volatile("" : "+v"(tf)); const v4u* fs = (const v4u*)(filt + (size_t)(o * HYW + c) * 8192); ((LAS v4u*)FL)[tf] = fs[tf]; ((LAS v4u*)FL)[tf + NTHR] = fs[tf + NTHR]; }
            __syncthreads();
            f32x4 acc[8][4];
#pragma unroll
            for (int i = 0; i < 8; ++i)
#pragma unroll
                for (int mt = 0; mt < 4; ++mt) acc[i][mt] = (f32x4){0.f, 0.f, 0.f, 0.f};
            const LAS unsigned* FLd = (const LAS unsigned*)FL; const int qbase = 4127 - fr + 8 * fq; const unsigned fsh = (qbase & 1) ? 16u : 0u;
            const LAS bf16* zrow = Z + fr * ZS + 8 * fq;
            bf16x8 af[6];
#define HYC_PIN2(a, b) asm volatile("" : "+v"(wr[a][0]), "+v"(wr[a][1]), "+v"(wr[a][2]), "+v"(wr[a][3]), "+v"(wr[a][4]), "+v"(wr[b][0]), "+v"(wr[b][1]), "+v"(wr[b][2]), "+v"(wr[b][3]), "+v"(wr[b][4]))
#define HYC_FRAG(dd) do { unsigned wr[6][5]; \
                _Pragma("unroll") for (int k = 0; k < 6; ++k) { const LAS unsigned* wp = FLd + ((qbase - 64 * (dd) - 16 * k) >> 1); \
                    _Pragma("unroll") for (int i5 = 0; i5 < 5; ++i5) wr[k][i5] = wp[i5]; } \
                HYC_PIN2(0, 1); HYC_PIN2(2, 3); HYC_PIN2(4, 5); \
                _Pragma("unroll") for (int k = 0; k < 6; ++k) { v4u fv; fv.x = __builtin_amdgcn_alignbit(wr[k][1], wr[k][0], fsh); fv.y = __builtin_amdgcn_alignbit(wr[k][2], wr[k][1], fsh); \
                    fv.z = __builtin_amdgcn_alignbit(wr[k][3], wr[k][2], fsh); fv.w = __builtin_amdgcn_alignbit(wr[k][4], wr[k][3], fsh); af[k] = __builtin_bit_cast(bf16x8, fv); } } while (0)
#define HYC_TB(j) (8 * w + (j))
#define HYC_ZLD2(buf, jp, dpv) do { _Pragma("unroll") for (int t2 = 0; t2 < 2; ++t2) { const int sb_ = (HYC_TB(2 * (jp) + t2) - (dpv)) & 63; const volatile LAS v4u* zp_ = (const volatile LAS v4u*)(zrow + 64 * sb_); \
                    zP[buf][t2][0] = zp_[0]; zP[buf][t2][1] = zp_[4]; } } while (0)
            v4u zP[2][2][2];
            HYC_ZLD2(0, 0, 0);
            for (int dp = 0; dp < 64; ++dp) {
                const int n_ = dp - 8 * w; const int nN = n_ < 0 ? 0 : (n_ > 8 ? 8 : n_);
                { const int d0 = nN > 0 ? dp - 64 : dp; HYC_FRAG(d0); }
#pragma unroll
                for (int jp = 0; jp < 4; ++jp) {
                    if (jp < 3) HYC_ZLD2((jp + 1) & 1, jp + 1, dp); else HYC_ZLD2(0, 0, dp + 1);
#pragma unroll
                    for (int t2 = 0; t2 < 2; ++t2) { const int j = 2 * jp + t2;
                        if (j > 0 && j == nN) HYC_FRAG(dp);
                        const bf16x8 z0 = __builtin_bit_cast(bf16x8, zP[jp & 1][t2][0]), z1 = __builtin_bit_cast(bf16x8, zP[jp & 1][t2][1]);
#pragma unroll
                        for (int mt = 0; mt < 4; ++mt) acc[j][mt] = __builtin_amdgcn_mfma_f32_16x16x32_bf16(af[mt + 2], z0, acc[j][mt], 0, 0, 0);
#pragma unroll
                        for (int mt = 0; mt < 4; ++mt) acc[j][mt] = __builtin_amdgcn_mfma_f32_16x16x32_bf16(af[mt], z1, acc[j][mt], 0, 0, 0); }
                }
            }
#undef HYC_PIN2
#undef HYC_FRAG
#undef HYC_TB
#undef HYC_ZLD2
            int el_ = tid; asm volatile("" : "+v"(el_)); const int efr = el_ & 15, efq = (el_ >> 4) & 3;
            const int gch = (o + 1) * HYW + c; const bf16* gsrc = hyT + (size_t)gch * M + efr * SEQ; const float w0 = sw[gch], w1 = sw[3 * HYW + gch], w2 = sw[6 * HYW + gch], bb = sb[gch], hbv = hbias[o * HYW + c];
#pragma unroll
            for (int i = 0; i < 8; ++i) { int t0i = 64 * (8 * w + i) + 4 * efq; asm volatile("" : "+v"(t0i));
#pragma unroll
                for (int mt = 0; mt < 4; ++mt) { const int t0 = t0i + 16 * mt; const bf16* p = gsrc + t0; const v2u gv = *(const v2u*)p;
                    float x[6]; { const float xm = bf1(p[-1]), xp = bf1(p[4]); x[0] = (t0 & (SEQ - 1)) != 0 ? xm : 0.f; x[5] = ((t0 + 4) & (SEQ - 1)) != 0 ? xp : 0.f; } x[1] = bflo(gv.x); x[2] = bfhi(gv.x); x[3] = bflo(gv.y); x[4] = bfhi(gv.y);
                    const v2u zv = *(const LAS v2u*)(Z + efr * ZS + t0); const float zz[4] = {bflo(zv.x), bfhi(zv.x), bflo(zv.y), bfhi(zv.y)};
#pragma unroll
                    for (int j = 0; j < 4; ++j) { const float gte = w0 * x[j] + w1 * x[j + 1] + w2 * x[j + 2] + bb; acc[i][mt][j] = gte * (acc[i][mt][j] + zz[j] * hbv); }
                    asm volatile("" ::: "memory"); } }
            __syncthreads();
            if (o == 0) {
#pragma unroll
                for (int i = 0; i < 8; ++i) { int t0i = 64 * (8 * w + i) + 4 * efq; asm volatile("" : "+v"(t0i));
#pragma unroll
                    for (int mt = 0; mt < 4; ++mt) { const int t0 = t0i + 16 * mt; v2u ov; ov.x = pk2(acc[i][mt][0], acc[i][mt][1]); ov.y = pk2(acc[i][mt][2], acc[i][mt][3]); *(LAS v2u*)(Z + efr * ZS + t0) = ov; } }
            } else {
#pragma unroll
                for (int i = 0; i < 8; ++i) { int t0i = 64 * (8 * w + i) + 4 * efq; asm volatile("" : "+v"(t0i));
#pragma unroll
                    for (int mt = 0; mt < 4; ++mt) { const int t0 = t0i + 16 * mt; v2u ov; ov.x = pk2(acc[i][mt][0], acc[i][mt][1]); ov.y = pk2(acc[i][mt][2], acc[i][mt][3]);
                        *(v2u*)(yaT + (size_t)c * M + (size_t)efr * SEQ + t0) = ov; }
                    asm volatile("" ::: "memory"); }
            }
        }
        __syncthreads();
    }
}
__device__ __forceinline__ void ya_transpose(const Frame& F) {
    unsigned char* ws_ = karg_ws(); const bf16* yT = (const bf16*)(ws_ + WS_HB); bf16* ya = (bf16*)(ws_ + WS_YA);
    LAS bf16* sT = (LAS bf16*)F.lds;
    const int ch = F.tid & 7, r = F.tid >> 3;
    v4u v[4];
    { const int gi = F.vcu < 8 * 256 ? F.vcu : 0; const int c0 = 64 * (gi & 7), t0 = 256 * (gi >> 3);
#pragma unroll
      for (int k = 0; k < 4; ++k) v[k] = *(const v4u*)(yT + (size_t)(c0 + r) * M + t0 + 64 * k + 8 * ch); }
    for (int gi = F.vcu; gi < 8 * 256; gi += F.G) {
        const int c0 = 64 * (gi & 7), t0 = 256 * (gi >> 3);
        v4u vn[4];
        { const int gn = gi + F.G < 8 * 256 ? gi + F.G : gi; const int cn = 64 * (gn & 7), tn = 256 * (gn >> 3);
#pragma unroll
          for (int k = 0; k < 4; ++k) vn[k] = *(const v4u*)(yT + (size_t)(cn + r) * M + tn + 64 * k + 8 * ch); }
#pragma unroll
        for (int k = 0; k < 4; ++k) { LAS bf16* d = sT + k * (64 * 66) + (8 * ch) * 66 + r; const unsigned w[4] = {v[k].x, v[k].y, v[k].z, v[k].w};
#pragma unroll
            for (int j = 0; j < 4; ++j) { d[(2 * j) * 66] = (bf16)(w[j] & 0xffffu); d[(2 * j + 1) * 66] = (bf16)(w[j] >> 16); } }
        __syncthreads();
#pragma unroll
        for (int k = 0; k < 4; ++k) { const LAS unsigned* sp = (const LAS unsigned*)(sT + k * (64 * 66) + r * 66 + 8 * ch); v4u o; o.x = sp[0]; o.y = sp[1]; o.z = sp[2]; o.w = sp[3];
            *(v4u*)(ya + (size_t)(t0 + 64 * k + r) * HYW + c0 + 8 * ch) = o; }
        __syncthreads();
#pragma unroll
        for (int k = 0; k < 4; ++k) v[k] = vn[k];
    }
}

constexpr int N_STEPS = 15;
#ifndef ONE_LAUNCH
#define ONE_LAUNCH 1
#endif
#ifndef STEP_MASK
#define STEP_MASK 0xFFFF
#endif
__device__ __forceinline__ bool gemm_desc(int st, int q, unsigned char* ws, pg8::Gemm& g, pg8::EpiGen& e) {
    bf16* XB = (bf16*)(ws + WS_XB); bf16* HB = (bf16*)(ws + WS_HB);
    e.ws = ws; e.aux = nullptr; e.O = HB; e.ldc = DM_; e.midk = 0;
    if (q == 0) {
        switch (st) {
        case 1: case 10: g = pg8::Gemm{XB, (const bf16*)(ws + (st == 10 ? WS_GU2 : WS_GU1)), M, 2 * FF, DM_}; e.mode = pg8::EM_SWIGLU; e.O = (bf16*)(ws + WS_ACT); e.ldc = FF; return true;
        case 2: case 11: g = pg8::Gemm{(const bf16*)(ws + WS_ACT), (const bf16*)(ws + (st == 11 ? WS_D2 : WS_D1)), M, DM_, FF}; e.mode = pg8::EM_HSUM; return true;
        case 4: g = pg8::Gemm{(const bf16*)(ws + WS_IN), XB, 3 * HYW, M, DM_}; e.mode = pg8::EM_HYT; e.O = (bf16*)(ws + WS_HYT); e.ldc = M; return true;
        case 7: g = pg8::Gemm{(const bf16*)(ws + WS_YA), (const bf16*)(ws + WS_HYO), M, DM_, HYW, (const bf16*)(ws + WS_YB), (const bf16*)(ws + WS_ATO)}; e.mode = pg8::EM_MERGEA; e.O = (bf16*)(ws + WS_MRG); e.aux = (const bf16*)(ws + WS_SGB); e.midk = 1; return true;
        case 8: g = pg8::Gemm{(const bf16*)(ws + WS_MRG), (const bf16*)(ws + WS_OUT), M, DM_, DM_}; e.mode = pg8::EM_HSUM; return true;
        case 13: g = pg8::Gemm{(const bf16*)(ws + WS_PB), (const bf16*)(ws + WS_PP), M, DM_, PLE}; e.mode = pg8::EM_PLAIN; e.O = (bf16*)(ws + WS_PBUF); return true;
        default: return false;
        }
    } else {
        switch (st) {
        case 4: g = pg8::Gemm{XB, (const bf16*)(ws + WS_IN) + (size_t)3 * HYW * DM_, M, INC - 3 * HYW, DM_}; e.mode = pg8::EM_QKVG; return true;
        case 13: g = pg8::Gemm{XB, (const bf16*)(ws + WS_PG), M, DM_, DM_}; e.mode = pg8::EM_PLEG; e.aux = (const bf16*)(ws + WS_PBUF); return true;
        default: return false;
        }
    }
}
__global__ void __launch_bounds__(NTHR, 2) fwd_kernel(Args args) {
    extern __shared__ __attribute__((aligned(16))) unsigned char lds[];
    const int step_lo = args.step_lo, step_hi = args.step_hi;
    if (threadIdx.x < 2) ((volatile LAS unsigned*)((LAS unsigned char*)lds + BARST_OFF))[threadIdx.x] = 0u;
    __syncthreads();
    const XcdBarrier bar = xcd_barrier_post((unsigned*)karg_ws(), (volatile LAS unsigned*)((LAS unsigned char*)lds + BARST_OFF));
    for (int st = step_lo; st < step_hi; ++st) {
        if (st > step_lo) { if (step_hi > 1000) cg::this_grid().sync(); xcd_barrier(bar); }
        if (!((STEP_MASK >> st) & 1)) continue;
        unsigned char* ws = karg_ws();
        int tid_ = threadIdx.x; asm volatile("" : "+v"(tid_));
        Frame F; F.lds = (LAS unsigned char*)lds; F.tid = tid_; F.lane = F.tid & 63; F.wave = __builtin_amdgcn_readfirstlane(F.tid >> 6);
        F.G = gridDim.x; { const int bx = blockIdx.x; F.vcu = (F.G % 8 == 0) ? (bx % 8) * (F.G / 8) + bx / 8 : bx; }
        bf16* XB = (bf16*)(ws + WS_XB); bf16* HB = (bf16*)(ws + WS_HB); float* RS = (float*)(ws + WS_RS); float* PART = (float*)(ws + WS_PART);
        switch (st) {
        case 0: if constexpr (STEP_MASK & 1) prologue(F); break;
        case 1: if constexpr ((STEP_MASK >> 1) & 1) filter_cols(F); break;
        case 5: if constexpr ((STEP_MASK >> 5) & 1) { qk_prep(F); hyena_phase(F); } break;
        case 6: if constexpr ((STEP_MASK >> 6) & 1) { ya_transpose(F); const attn_body::AttnTensors AT{(const attn_body::bf16*)(ws + WS_Q), (const attn_body::bf16*)(ws + WS_K), (const attn_body::bf16*)(ws + WS_V), (attn_body::bf16*)(ws + WS_YB)};
            const attn_body::StaticOrder S((int)F.G, (int)blockIdx.x); attn_body::attn_phase<attn_body::StaticOrder>((char*)lds, AT, S); } break;
        case 12: if constexpr ((STEP_MASK >> 12) & 1) {
            { const f32x4* p4 = (const f32x4*)IN(1); v2u* pb = (v2u*)(ws + WS_PB);
              for (int i = F.vcu * NTHR + F.tid; i < M * PLE / 4; i += F.G * NTHR) { const f32x4 v = p4[i]; v2u o; o.x = pk2(v[0], v[1]); o.y = pk2(v[2], v[3]); pb[i] = o; } } } break;
        default: break;
        }
        if (st == 3 || st == 9 || st == 12 || st == 14) {
            const float* gp = IN(st == 3 ? 3 : st == 9 ? 8 : st == 12 ? 27 : 32);
            elem_pass(F, XB, HB, PART, gp, (st == 3 || st == 12) ? 0.5f : 1.0f, karg_out(), RS, st == 14);
        }
#ifndef NO_GEMM
        for (int q = 0; q < 2; ++q) {
            pg8::Gemm g; pg8::EpiGen e;
            if (!gemm_desc(st, q, ws, g, e)) break;
            pg8::StaticOrder S; S.init(g.M, g.N, F.G, (int)blockIdx.x); S.dual = e.midk; S.wgm = (g.N > 4096 && g.N < 65536) ? 8 : 4;
            pg8::gemm_phase<pg8::EpiGen, pg8::StaticOrder, true, true>(F.lds, g, S, e);
            __syncthreads();
        }
#endif
    }
}

extern "C" void kernel_launch(void* const* d_in, const int* in_sizes, int n_in, void* d_out, int out_size, void* d_ws, size_t ws_size, hipStream_t stream) {
    static int grid = 0;
    if (grid == 0) {
        if (n_in != 35 || ws_size < WS_END) { fprintf(stderr, "kernel_launch: unexpected n_in %d / ws %zu\n", n_in, ws_size); grid = -1; return; }
        int dev = 0, cus = 0, per_cu = 0;
        (void)hipGetDevice(&dev); (void)hipDeviceGetAttribute(&cus, hipDeviceAttributeMultiprocessorCount, dev);
        if (hipFuncSetAttribute((const void*)fwd_kernel, hipFuncAttributeMaxDynamicSharedMemorySize, LDS_BYTES) != hipSuccess) { fprintf(stderr, "kernel_launch: hipFuncSetAttribute failed\n"); grid = -1; return; }
        if (hipOccupancyMaxActiveBlocksPerMultiprocessor(&per_cu, (const void*)fwd_kernel, NTHR, LDS_BYTES) != hipSuccess || per_cu < 1) { fprintf(stderr, "kernel_launch: occupancy query says %d\n", per_cu); per_cu = 1; }
        (void)hipGetLastError();
        grid = cus > 0 ? cus : 256;
    }
    if (grid < 0) return;
    if (hipMemsetAsync(d_ws, 0, CTL_ZERO_BYTES, stream) != hipSuccess) { fprintf(stderr, "kernel_launch: memset of the barrier words failed\n"); return; }
    Args a{};
    for (int i = 0; i < 35; ++i) a.in[i] = (const float*)d_in[i];
    a.out = (float*)d_out; a.ws = (unsigned char*)d_ws;
#if ONE_LAUNCH
    a.step_lo = 0; a.step_hi = N_STEPS;
    void* kargs[] = {&a};
    hipError_t e = hipLaunchCooperativeKernel((const void*)fwd_kernel, dim3(grid), dim3(NTHR), kargs, LDS_BYTES, stream);
    if (e != hipSuccess) fprintf(stderr, "cooperative launch failed: %s (grid %d)\n", hipGetErrorString(e), grid);
#else
    for (int st = 0; st < N_STEPS; ++st) { a.step_lo = st; a.step_hi = st + 1; hipLaunchKernelGGL(fwd_kernel, dim3(grid), dim3(NTHR), LDS_BYTES, stream, a); }
#endif
}
```
